# Optimizing an MI355X kernel written in HIP

```python
import jax
import jax.numpy as jnp
from jax import lax
import numpy as np

D_MODEL = 1024
BATCH = 8
SEQ = 4096
DEPTH = 1

MLA_HEADS = 8
MLA_NOPE = 64
MLA_ROPE = 32
MLA_V = 64
MLA_Q_RANK = 384
MLA_KV_RANK = 256
ROPE_THETA = 10000.0
Q_BLOCK = 128
M_HEADS = 4
M_DK = 64
M_DV = 128
M_CHUNK = 64
CONV_W = 4
F_BIAS_LO = 3.0
F_BIAS_HI = 6.0
MLA_OUT = MLA_HEADS * MLA_V
M_OUT = M_HEADS * M_DV
D_MIX = MLA_OUT + M_OUT
D_FF = ((-(-8 * D_MODEL // 3)) + 255) // 256 * 256
IN_SPLITS = (MLA_Q_RANK, MLA_KV_RANK, MLA_ROPE, 2 * M_HEADS * M_DK, M_OUT, M_OUT, M_HEADS, M_HEADS)
D_IN = sum(IN_SPLITS)
IN_OFFSETS = tuple(int(v) for v in np.cumsum(IN_SPLITS)[:-1])
EPS = 1e-6

kernel_name = "hybrid_mla_mlstm_adaln_layer"


def rms_norm(x, g):
    xf = x.astype(jnp.float32)
    y = xf * lax.rsqrt(jnp.mean(xf * xf, axis=-1, keepdims=True) + EPS)
    return (y * g.astype(jnp.float32)).astype(x.dtype)


def head_norm(y, g, n_heads):
    b, s, w = y.shape
    yh = y.reshape(b, s, n_heads, w // n_heads)
    return rms_norm(yh, g.reshape(n_heads, w // n_heads)).reshape(b, s, w)


def apply_rope(x, positions):
    half = x.shape[-1] // 2
    inv = ROPE_THETA ** (-jnp.arange(half, dtype=jnp.float32) / half)
    ang = positions.astype(jnp.float32)[..., None] * inv
    cos = jnp.cos(ang)[:, :, None, :]
    sin = jnp.sin(ang)[:, :, None, :]
    xf = x.astype(jnp.float32)
    x1, x2 = xf[..., :half], xf[..., half:]
    return jnp.concatenate([x1 * cos - x2 * sin, x2 * cos + x1 * sin], axis=-1).astype(x.dtype)


def mla(q_lat, kv_lat, kr_lat, positions, g_q, w_uq, g_kv, w_ukv):
    b, s, _ = q_lat.shape
    q = (rms_norm(q_lat, g_q) @ w_uq).reshape(b, s, MLA_HEADS, MLA_NOPE + MLA_ROPE)
    q_nope = q[..., :MLA_NOPE]
    q_rope = apply_rope(q[..., MLA_NOPE:], positions)
    kv = (rms_norm(kv_lat, g_kv) @ w_ukv).reshape(b, s, MLA_HEADS, MLA_NOPE + MLA_V)
    k_nope = kv[..., :MLA_NOPE]
    v = kv[..., MLA_NOPE:]
    k_rope = apply_rope(kr_lat[:, :, None, :], positions)[:, :, 0, :]
    scale = (MLA_NOPE + MLA_ROPE) ** -0.5
    nb = s // Q_BLOCK
    qn_b = q_nope.reshape(b, nb, Q_BLOCK, MLA_HEADS, MLA_NOPE).transpose(1, 0, 2, 3, 4)
    qr_b = q_rope.reshape(b, nb, Q_BLOCK, MLA_HEADS, MLA_ROPE).transpose(1, 0, 2, 3, 4)
    starts = jnp.arange(nb, dtype=jnp.int32) * Q_BLOCK
    kpos = jnp.arange(s, dtype=jnp.int32)

    def block(args):
        qn, qr, start = args
        sc = (jnp.einsum('bqhd,bkhd->bhqk', qn, k_nope, preferred_element_type=jnp.float32)
              + jnp.einsum('bqhr,bkr->bhqk', qr, k_rope, preferred_element_type=jnp.float32)) * scale
        qpos = start + jnp.arange(Q_BLOCK, dtype=jnp.int32)
        causal = kpos[None, :] <= qpos[:, None]
        sc = jnp.where(causal, sc, -jnp.inf)
        p = jax.nn.softmax(sc, axis=-1).astype(v.dtype)
        return jnp.einsum('bhqk,bkhd->bqhd', p, v)

    out = lax.map(block, (qn_b, qr_b, starts))
    return out.transpose(1, 0, 2, 3, 4).reshape(b, s, MLA_HEADS * MLA_V)


def causal_conv(x, w, bias):
    ch = x.shape[-1]
    y = lax.conv_general_dilated(x, w[:, None, :].astype(x.dtype), window_strides=(1,),
                                 padding=[(CONV_W - 1, 0)], dimension_numbers=('NWC', 'WIO', 'NWC'),
                                 feature_group_count=ch)
    return y + bias


def mlstm(q, k, v, o_pre, i_pre, f_pre):
    f32 = jnp.float32
    b, s, h, _ = q.shape
    L = M_CHUNK
    nc = s // L

    def chunk(t):
        return t.reshape(b, nc, L, h, t.shape[-1]).transpose(0, 3, 1, 2, 4)

    qc = chunk(q.astype(f32))
    kc = chunk(k.astype(f32) * (M_DK ** -0.5))
    vc = chunk(v.astype(f32))
    ig = i_pre.astype(f32).reshape(b, nc, L, h).transpose(0, 3, 1, 2)
    lf = jax.nn.log_sigmoid(f_pre.astype(f32)).reshape(b, nc, L, h).transpose(0, 3, 1, 2)
    bcum = jnp.cumsum(lf, axis=-1)
    b_tot = bcum[..., -1]

    g = b_tot[..., None] - bcum + ig
    m_loc = jnp.max(g, axis=-1)
    wgt = jnp.exp(g - m_loc[..., None])
    dC = jnp.einsum('bhcl,bhclv,bhclk->bhcvk', wgt, vc, kc)
    dn = jnp.einsum('bhcl,bhclk->bhck', wgt, kc)

    def step(carry, inp):
        C, n, m = carry
        dC_c, dn_c, ml_c, bt_c = inp
        m_new = jnp.maximum(bt_c + m, ml_c)
        a = jnp.exp(bt_c + m - m_new)
        e = jnp.exp(ml_c - m_new)
        C_new = a[..., None, None] * C + e[..., None, None] * dC_c
        n_new = a[..., None] * n + e[..., None] * dn_c
        return (C_new, n_new, m_new), (C, n, m)

    init = (jnp.zeros((b, h, M_DV, M_DK), f32), jnp.zeros((b, h, M_DK), f32), jnp.zeros((b, h), f32))
    xs = (dC.transpose(2, 0, 1, 3, 4), dn.transpose(2, 0, 1, 3), m_loc.transpose(2, 0, 1), b_tot.transpose(2, 0, 1))
    _, (C0, n0, m0) = lax.scan(step, init, xs)
    C0 = C0.transpose(1, 2, 0, 3, 4)
    n0 = n0.transpose(1, 2, 0, 3)
    m0 = m0.transpose(1, 2, 0)

    causal = jnp.tril(jnp.ones((L, L), dtype=bool))
    logD = jnp.where(causal, bcum[..., :, None] - bcum[..., None, :] + ig[..., None, :], -jnp.inf)
    log_inter = bcum + m0[..., None]
    m_t = jnp.maximum(log_inter, jnp.max(logD, axis=-1))
    Dm = jnp.exp(logD - m_t[..., None])
    inter = jnp.exp(log_inter - m_t)
    sc = jnp.einsum('bhctk,bhcsk->bhcts', qc, kc) * Dm
    num = jnp.einsum('bhcts,bhcsv->bhctv', sc, vc) + inter[..., None] * jnp.einsum('bhctk,bhcvk->bhctv', qc, C0)
    den = jnp.sum(sc, axis=-1) + inter * jnp.einsum('bhctk,bhck->bhct', qc, n0)
    hh = num / jnp.maximum(jnp.abs(den), jnp.exp(-m_t))[..., None]
    hh = hh.transpose(0, 2, 3, 1, 4).reshape(b, s, h * M_DV)
    return (jax.nn.sigmoid(o_pre.astype(f32)) * hh).astype(o_pre.dtype)


def setup_inputs(seed: int = 0) -> dict:
    key = jax.random.key(seed)
    ks = jax.random.split(key, 24)
    f32 = jnp.float32

    def nrm(k, shape, scale):
        return jax.random.normal(k, shape, f32) * scale

    def gain(k, shape):
        return 1.0 + 0.02 * jax.random.normal(k, shape, f32)

    L = DEPTH
    x = nrm(ks[0], (BATCH, SEQ, D_MODEL), 1.0)
    c = nrm(ks[1], (BATCH, D_MODEL), 1.0)
    positions = jnp.broadcast_to(jnp.arange(SEQ, dtype=jnp.int32)[None, :], (BATCH, SEQ))
    w_ada = nrm(ks[2], (L, D_MODEL, 6 * D_MODEL), D_MODEL ** -0.5)
    b_ada = nrm(ks[3], (L, 6 * D_MODEL), 0.02)
    g_mix = gain(ks[4], (L, D_MODEL))
    w_in = nrm(ks[5], (L, D_MODEL, D_IN), D_MODEL ** -0.5)
    g_q = gain(ks[6], (L, MLA_Q_RANK))
    w_uq = nrm(ks[7], (L, MLA_Q_RANK, MLA_HEADS * (MLA_NOPE + MLA_ROPE)), MLA_Q_RANK ** -0.5)
    g_kv = gain(ks[8], (L, MLA_KV_RANK))
    w_ukv = nrm(ks[9], (L, MLA_KV_RANK, MLA_HEADS * (MLA_NOPE + MLA_V)), MLA_KV_RANK ** -0.5)
    conv_w = nrm(ks[10], (L, CONV_W, 2 * M_HEADS * M_DK), CONV_W ** -0.5)
    conv_b = nrm(ks[11], (L, 2 * M_HEADS * M_DK), 0.02)
    i_bias = nrm(ks[12], (L, M_HEADS), 0.1)
    f_bias = jnp.linspace(F_BIAS_LO, F_BIAS_HI, M_HEADS, dtype=f32)[None, :] + nrm(ks[13], (L, M_HEADS), 0.1)
    b_gates = jnp.concatenate([i_bias, f_bias], axis=-1)
    g_out_mla = gain(ks[14], (L, MLA_OUT))
    g_out_mlstm = gain(ks[15], (L, M_OUT))
    w_out = nrm(ks[16], (L, D_MIX, D_MODEL), D_MIX ** -0.5)
    g_ffn = gain(ks[17], (L, D_MODEL))
    w_gate = nrm(ks[18], (L, D_MODEL, D_FF), D_MODEL ** -0.5)
    w_up = nrm(ks[19], (L, D_MODEL, D_FF), D_MODEL ** -0.5)
    w_down = nrm(ks[20], (L, D_FF, D_MODEL), D_FF ** -0.5)
    g_final = gain(ks[21], (D_MODEL,))
    return {"x": x, "c": c, "positions": positions, "w_ada": w_ada, "b_ada": b_ada,
            "g_mix": g_mix, "w_in": w_in, "g_q": g_q, "w_uq": w_uq, "g_kv": g_kv, "w_ukv": w_ukv,
            "conv_w": conv_w, "conv_b": conv_b, "b_gates": b_gates,
            "g_out_mla": g_out_mla, "g_out_mlstm": g_out_mlstm, "w_out": w_out,
            "g_ffn": g_ffn, "w_gate": w_gate, "w_up": w_up, "w_down": w_down, "g_final": g_final}


def reference(x, c, positions, w_ada, b_ada, g_mix, w_in, g_q, w_uq, g_kv, w_ukv,
              conv_w, conv_b, b_gates, g_out_mla, g_out_mlstm, w_out,
              g_ffn, w_gate, w_up, w_down, g_final):
    b, s, _ = x.shape
    cond = jax.nn.silu(c)
    for l in range(DEPTH):
        mod = cond @ w_ada[l] + b_ada[l]
        sh_a, sc_a, gt_a, sh_f, sc_f, gt_f = [m[:, None, :] for m in jnp.split(mod, 6, axis=-1)]

        h = rms_norm(x, g_mix[l]) * (1.0 + sc_a) + sh_a
        z = h @ w_in[l]
        q_lat, kv_lat, kr_lat, z_qk, z_v, z_o, z_i, z_f = jnp.split(z, IN_OFFSETS, axis=-1)
        y_a = mla(q_lat, kv_lat, kr_lat, positions, g_q[l], w_uq[l], g_kv[l], w_ukv[l])
        qk = jax.nn.silu(causal_conv(z_qk, conv_w[l], conv_b[l]))
        q_m = qk[..., :M_HEADS * M_DK].reshape(b, s, M_HEADS, M_DK)
        k_m = qk[..., M_HEADS * M_DK:].reshape(b, s, M_HEADS, M_DK)
        v_m = z_v.reshape(b, s, M_HEADS, M_DV)
        y_b = mlstm(q_m, k_m, v_m, z_o, z_i + b_gates[l, :M_HEADS], z_f + b_gates[l, M_HEADS:])
        y = jnp.concatenate([head_norm(y_a, g_out_mla[l], MLA_HEADS),
                             head_norm(y_b, g_out_mlstm[l], M_HEADS)], axis=-1)
        x = x + gt_a * (y @ w_out[l])

        h = rms_norm(x, g_ffn[l]) * (1.0 + sc_f) + sh_f
        x = x + gt_f * ((jax.nn.silu(h @ w_gate[l]) * (h @ w_up[l])) @ w_down[l])
    return rms_norm(x, g_final)
```

```cpp
#include <hip/hip_runtime.h>
#include <hip/hip_cooperative_groups.h>
#include <cstdio>
#include <cstdint>
namespace cg = cooperative_groups;

#define LAS __attribute__((address_space(3)))
typedef unsigned short bf16_t;
typedef short bf16x8 __attribute__((ext_vector_type(8)));
typedef short s16x4 __attribute__((ext_vector_type(4)));
typedef float f32x4 __attribute__((ext_vector_type(4)));
typedef float f32x16 __attribute__((ext_vector_type(16)));
typedef unsigned u32x4 __attribute__((ext_vector_type(4)));
typedef unsigned u32x2 __attribute__((ext_vector_type(2)));
typedef float f32x2_t __attribute__((ext_vector_type(2)));
typedef __bf16 bf16x2_t __attribute__((ext_vector_type(2)));

constexpr int NB = 8, SEQ = 4096, DM = 1024, MROWS = NB * SEQ;
constexpr int NH = 8, DQK = 96, DNOPE = 64, DROPE = 32, DV = 64, QRANK = 384, KVRANK = 256;
constexpr int MH = 4, MDK = 64, MDV = 128, CHUNK = 64, NCHUNK = SEQ / CHUNK, NCH_TOT = NB * MH * NCHUNK;
constexpr int DIN = 2216, DINP = 2304, DFF = 2816, DMIX = 1024;
constexpr int ZQ = 0, ZKV = 384, ZKR = 640, ZQK = 672, ZV = 1184, ZO = 1696, ZI = 2208;
constexpr float EPS = 1e-6f;
constexpr float QSCALE = 0.10206207261596575f * 1.4426950408889634f;

constexpr size_t MiB = 1u << 20;
constexpr size_t WS_MOD = 0, WS_COS = 1 * MiB, WS_SIN = 3 * MiB, WS_RSTDQ = 5 * MiB, WS_RSTDKV = 5 * MiB + 256 * 1024;
constexpr size_t WS_GATES = 6 * MiB, WS_MLOC = 7 * MiB, WS_BTOT = 7 * MiB + 64 * 1024, WS_M0 = 7 * MiB + 128 * 1024;
constexpr size_t WS_BARW = 9 * MiB + 512 * 1024;
constexpr size_t WS_PCNT = 9 * MiB + 768 * 1024;
constexpr size_t WS_XBUF = 10 * MiB;
constexpr size_t WS_DN = 8 * MiB, WS_N0 = 8 * MiB + 512 * 1024;
constexpr size_t WS_BIN = 16 * MiB, WS_BQ = 21 * MiB, WS_BKV = 22 * MiB, WS_BOUT = 23 * MiB, WS_BGU = 25 * MiB, WS_BD = 36 * MiB;
constexpr size_t WS_KROPE = 42 * MiB;
constexpr size_t WS_HN = 48 * MiB;
constexpr size_t WS_Z = 112 * MiB;
constexpr size_t WS_Q = 256 * MiB, WS_KN = 304 * MiB, WS_VT = 336 * MiB, WS_QM = 368 * MiB, WS_KM = 384 * MiB;
constexpr size_t WS_DC = 400 * MiB, WS_C0 = 464 * MiB, WS_END = 496 * MiB;
constexpr size_t WS_ACT = 112 * MiB;

__device__ __forceinline__ unsigned cvtpk(float lo, float hi) { f32x2_t v = {lo, hi}; bf16x2_t b = __builtin_convertvector(v, bf16x2_t); return __builtin_bit_cast(unsigned, b); }
__device__ __forceinline__ float bf2f(unsigned short u) { return __uint_as_float(((unsigned)u) << 16); }
__device__ __forceinline__ float bflo(unsigned u) { return __uint_as_float(u << 16); }
__device__ __forceinline__ float bfhi(unsigned u) { return __uint_as_float(u & 0xffff0000u); }
__device__ __forceinline__ unsigned short f2bf(float f) { return (unsigned short)(cvtpk(f, 0.f) & 0xffffu); }
template <int CTRL> __device__ __forceinline__ float dpp_f(float v) { return __uint_as_float((unsigned)__builtin_amdgcn_update_dpp(0, (int)__float_as_uint(v), CTRL, 0xF, 0xF, true)); }
__device__ __forceinline__ float wave_sum(float v) {
    v += dpp_f<0xB1>(v);
    v += dpp_f<0x4E>(v);
    v += dpp_f<0x141>(v);
    v += dpp_f<0x140>(v);
    { const auto r = __builtin_amdgcn_permlane16_swap(__float_as_uint(v), __float_as_uint(v), false, false); v = __uint_as_float(r[0]) + __uint_as_float(r[1]); }
    { const auto r = __builtin_amdgcn_permlane32_swap(__float_as_uint(v), __float_as_uint(v), false, false); v = __uint_as_float(r[0]) + __uint_as_float(r[1]); }
    return v;
}
__device__ __forceinline__ float wave_max(float v) {
#pragma unroll
    for (int o = 1; o < 64; o <<= 1) v = fmaxf(v, __shfl_xor(v, o));
    return v;
}
__device__ __forceinline__ int fresh_lane() { int l; asm volatile("v_mbcnt_lo_u32_b32 %0, -1, 0\n\tv_mbcnt_hi_u32_b32 %0, -1, %0" : "=v"(l)); return l & 63; }
__device__ __forceinline__ int crow(int r, int hi) { return (r & 3) + 8 * (r >> 2) + 4 * hi; }
__device__ __forceinline__ float siluf(float x) { return x * __builtin_amdgcn_rcpf(1.f + __expf(-x)); }
__device__ __forceinline__ float sigmoidf_(float x) { return __builtin_amdgcn_rcpf(1.f + __expf(-x)); }
__device__ __forceinline__ float logsigmoidf_(float x) { return fminf(x, 0.f) - log1pf(expf(-fabsf(x))); }

namespace pg8 {
constexpr int BM = 256, BK = 64, HALF = 128, HTB = HALF * BK * 2, STAGE_BYTES = 8 * HTB, NXCD = 8, WGM = 8;
__host__ __device__ __forceinline__ int lds_byte(int r, int c) { const int st = (r >> 4) * 2 + (c >> 5), rr = r & 15, cc = c & 31, ob = rr * 64 + cc * 2; return st * 1024 + (ob ^ (((ob >> 9) & 1) << 5)); }
__host__ __device__ __forceinline__ void stage_rc(int b, int& R, int& C) { const int st = b / 1024, sb = b % 1024, swz = sb ^ (((sb >> 9) & 1) << 5); R = (st >> 1) * 16 + swz / 64; C = (st & 1) * 32 + (swz % 64) / 2; }
__host__ __device__ __forceinline__ int perm32(int rho) { const int n = rho >> 4, i = rho & 15; return 8 * (i >> 2) + 4 * n + (i & 3); }
struct Unit { int pm, pn; };
struct Gemm { const bf16_t* A; const bf16_t* Bt; int M, N, K, lda; };
struct StaticOrder {
    int nM, nN, nwg, G, c;
    __device__ void init(int M, int N, int G_, int c_) { nM = M / BM; nN = N / BM; nwg = nM * nN; G = G_; c = c_; }
    __device__ bool next(int i, Unit& u) const {
        const long L = (long)i * G + c; if (L >= nwg) return false;
        int wgid = (int)L; { const int q = nwg / NXCD, r = nwg % NXCD, xcd = wgid % NXCD, off = wgid / NXCD; wgid = (xcd < r ? xcd * (q + 1) : r * (q + 1) + (xcd - r) * q) + off; }
        const int nig = WGM * nN, gid = wgid / nig, fm = gid * WGM, gsz = (nM - fm) < WGM ? (nM - fm) : WGM;
        u.pm = fm + ((wgid % nig) % gsz); u.pn = (wgid % nig) / gsz; return true;
    }
};
struct NoHook { __device__ __forceinline__ void operator()(const Unit&, int) const {} };
template <class Epi, bool ALIGN_EPI, class Hook = NoHook>
__device__ __forceinline__ void gemm_phase(LAS unsigned char* lds, const Gemm g, const StaticOrder& S, const Epi& E, const int wave_id, const Hook& H = Hook()) {
    const int lane = fresh_lane();
    const int wid = wave_id, tid = wid * 64 + lane, wr = wid >> 2, wc = wid & 3, fr = lane & 15, fq = lane >> 4;
    const int K = g.K, nt = K / BK, lda = g.lda;
    unsigned voffA[2], voffB[2];
#pragma unroll
    for (int i = 0; i < 2; ++i) { int R, C; stage_rc(tid * 16 + i * 8192, R, C); const int Rb = (R & ~31) + perm32(R & 31);
        voffA[i] = (unsigned)(R * lda + C) * 2u; voffB[i] = (unsigned)(Rb * K + C) * 2u; }
    const size_t kstep = (size_t)(BK * 2);
    const size_t hstepA = (size_t)HALF * lda * 2, hstepB = (size_t)HALF * K * 2;
    const size_t tstepA = 2 * hstepA, tstepB = 2 * hstepB;
    const unsigned ldsw = (unsigned)wid * 1024u;
    const int aoff = lds_byte(wr * 64 + fr, fq * 8), boff = lds_byte(wc * 32 + fr, fq * 8);
#define PG8_SA(b, h) (((b) * 2 + (h)) * HTB)
#define PG8_SB(b, h) ((4 + (b) * 2 + (h)) * HTB)
#define PG8_STAGE(bufoff, gbase, voff) do { _Pragma("unroll") for (int _i = 0; _i < 2; ++_i) \
        __builtin_amdgcn_global_load_lds((const unsigned*)((const char*)(gbase) + (voff)[_i]), (LAS unsigned*)(lds + (bufoff) + ldsw + _i * 8192), 16, 0, 0); } while (0)
#define PG8_LDA(dst, b, h) do { _Pragma("unroll") for (int m = 0; m < 4; ++m) _Pragma("unroll") for (int k = 0; k < 2; ++k) dst[m][k] = *(const LAS bf16x8*)(lds + PG8_SA(b, h) + aoff + m * 2048 + k * 1024); } while (0)
#define PG8_LDB(dst, b, h) do { _Pragma("unroll") for (int n = 0; n < 2; ++n) _Pragma("unroll") for (int k = 0; k < 2; ++k) dst[n][k] = *(const LAS bf16x8*)(lds + PG8_SB(b, h) + boff + n * 2048 + k * 1024); } while (0)
#define PG8_MMA(ai, bj, At, Bt) do { __builtin_amdgcn_s_setprio(1); _Pragma("unroll") for (int m = 0; m < 4; ++m) _Pragma("unroll") for (int n = 0; n < 2; ++n) _Pragma("unroll") for (int k = 0; k < 2; ++k) \
        acc[ai][bj][m][n] = __builtin_amdgcn_mfma_f32_16x16x32_bf16(Bt[n][k], At[m][k], acc[ai][bj][m][n], 0, 0, 0); __builtin_amdgcn_s_setprio(0); } while (0)
#define PG8_WAIT_V(n) asm volatile("s_waitcnt vmcnt(" #n ")" ::: "memory")
#define PG8_WAIT_L(n) asm volatile("s_waitcnt lgkmcnt(" #n ")" ::: "memory")
#define PG8_BAR __builtin_amdgcn_s_barrier()
#define PG8_SCHED __builtin_amdgcn_sched_barrier(0)
    Unit cur, nxt; int ui = 0;
    if (!S.next(0, cur)) return;
    f32x4 acc[2][2][4][2];
#pragma unroll
    for (int a = 0; a < 2; ++a)
#pragma unroll
        for (int b = 0; b < 2; ++b)
#pragma unroll
            for (int m = 0; m < 4; ++m)
#pragma unroll
                for (int n = 0; n < 2; ++n) acc[a][b][m][n] = (f32x4){0.f, 0.f, 0.f, 0.f};
    bf16x8 At[4][2], B0[2][2], B1[2][2];
    const char* cA = (const char*)g.A + (size_t)cur.pm * tstepA; const char* cB = (const char*)g.Bt + (size_t)cur.pn * tstepB;
    PG8_STAGE(PG8_SB(0, 0), cB, voffB); PG8_STAGE(PG8_SB(0, 1), cB + hstepB, voffB); PG8_STAGE(PG8_SA(0, 0), cA, voffA); PG8_STAGE(PG8_SA(0, 1), cA + hstepA, voffA);
    if (wr == 1) PG8_BAR;
    PG8_WAIT_V(2); PG8_BAR;
    PG8_STAGE(PG8_SB(1, 0), cB + kstep, voffB); PG8_STAGE(PG8_SA(1, 0), cA + kstep, voffA); PG8_STAGE(PG8_SB(1, 1), cB + hstepB + kstep, voffB);
    PG8_WAIT_V(6); PG8_BAR;
    for (;;) {
        const bool has_next = S.next(ui + 1, nxt);
        const char* nA = has_next ? (const char*)g.A + (size_t)nxt.pm * tstepA : cA; const char* nB = has_next ? (const char*)g.Bt + (size_t)nxt.pn * tstepB : cB;
        for (int t = 0; t < nt; t += 2) {
            const bool last = (t == nt - 2);
            const char* a1 = cA + (size_t)(t + 1) * kstep;
            const char* a2 = last ? nA : cA + (size_t)(t + 2) * kstep; const char* b2 = last ? nB : cB + (size_t)(t + 2) * kstep;
            const char* a3 = a2 + kstep; const char* b3 = b2 + kstep;
            PG8_LDB(B0, 0, 0); PG8_LDB(B1, 0, 1); PG8_SCHED; PG8_LDA(At, 0, 0); PG8_STAGE(PG8_SA(1, 1), a1 + hstepA, voffA);
            PG8_WAIT_V(8); PG8_WAIT_L(0); PG8_BAR; PG8_MMA(0, 0, At, B0); PG8_MMA(0, 1, At, B1); PG8_BAR; PG8_SCHED;
            PG8_LDA(At, 0, 1); PG8_STAGE(PG8_SB(0, 0), b2, voffB); PG8_STAGE(PG8_SB(0, 1), b2 + hstepB, voffB); PG8_STAGE(PG8_SA(0, 0), a2, voffA);
            PG8_WAIT_V(8); PG8_WAIT_L(0); PG8_BAR; PG8_MMA(1, 0, At, B0); PG8_MMA(1, 1, At, B1); PG8_BAR; PG8_SCHED;
            PG8_LDB(B0, 1, 0); PG8_LDB(B1, 1, 1); PG8_SCHED; PG8_LDA(At, 1, 0); PG8_STAGE(PG8_SA(0, 1), a2 + hstepA, voffA);
            PG8_WAIT_V(8); PG8_WAIT_L(0); PG8_BAR; PG8_MMA(0, 0, At, B0); PG8_MMA(0, 1, At, B1); PG8_BAR; PG8_SCHED;
            PG8_LDA(At, 1, 1); PG8_STAGE(PG8_SB(1, 0), b3, voffB); PG8_STAGE(PG8_SB(1, 1), b3 + hstepB, voffB); PG8_STAGE(PG8_SA(1, 0), a3, voffA);
            PG8_WAIT_V(8); PG8_WAIT_L(0); PG8_BAR; PG8_MMA(1, 0, At, B0); PG8_MMA(1, 1, At, B1); PG8_BAR; PG8_SCHED;
        }
        if constexpr (ALIGN_EPI) { if (wr == 0) PG8_BAR; }
        E(acc, cur, wr, wc, fr, fq);
        H(cur, wid);
        if (!has_next) break;
#pragma unroll
        for (int a = 0; a < 2; ++a)
#pragma unroll
            for (int b = 0; b < 2; ++b)
#pragma unroll
                for (int m = 0; m < 4; ++m)
#pragma unroll
                    for (int n = 0; n < 2; ++n) acc[a][b][m][n] = (f32x4){0.f, 0.f, 0.f, 0.f};
        cur = nxt; cA = nA; cB = nB; ++ui;
        if constexpr (ALIGN_EPI) { if (wr == 1) PG8_BAR; }
    }
    PG8_WAIT_V(0);
    if constexpr (!ALIGN_EPI) { if (wr == 0) PG8_BAR; }
    PG8_BAR;
#undef PG8_SA
#undef PG8_SB
#undef PG8_STAGE
#undef PG8_LDA
#undef PG8_LDB
#undef PG8_MMA
#undef PG8_WAIT_V
#undef PG8_WAIT_L
#undef PG8_BAR
#undef PG8_SCHED
}
}

typedef f32x4 AccT[2][2][4][2];
#define EPI_LOOP_BEGIN \
    _Pragma("unroll") for (int ai = 0; ai < 2; ++ai) _Pragma("unroll") for (int m = 0; m < 4; ++m) { const int row = u.pm * 256 + ai * 128 + wr * 64 + m * 16 + fr; \
    _Pragma("unroll") for (int bj = 0; bj < 2; ++bj) { const int col = u.pn * 256 + bj * 128 + wc * 32 + 8 * fq; const f32x4 v0 = acc[ai][bj][m][0], v1 = acc[ai][bj][m][1];
#define EPI_LOOP_END } asm volatile("" ::: "memory"); }

struct EpiIn {
    bf16_t* Z; float* gates; const float* bg;
    __device__ __forceinline__ void operator()(const AccT& acc, const pg8::Unit& u, int wr, int wc, int fr, int fq) const {
        { const int l_ = fresh_lane(); fr = l_ & 15; fq = l_ >> 4; }
        EPI_LOOP_BEGIN
            u32x4 w; w.x = cvtpk(v0[0], v0[1]); w.y = cvtpk(v0[2], v0[3]); w.z = cvtpk(v1[0], v1[1]); w.w = cvtpk(v1[2], v1[3]);
            *(u32x4*)(Z + (size_t)row * DINP + col) = w;
            if (col == ZI) {
                const f32x4 b0 = *(const f32x4*)(bg), b1 = *(const f32x4*)(bg + 4);
                *(f32x4*)(gates + (size_t)row * 8) = v0 + b0; *(f32x4*)(gates + (size_t)row * 8 + 4) = v1 + b1;
            }
        EPI_LOOP_END
    }
};
struct EpiQ {
    bf16_t* Q;
    __device__ __forceinline__ void operator()(const AccT& acc, const pg8::Unit& u, int wr, int wc, int fr, int fq) const {
        { const int l_ = fresh_lane(); fr = l_ & 15; fq = l_ >> 4; }
        const int row0 = u.pm * 256 + wr * 64 + fr; const int b = row0 >> 12, s0 = row0 & 4095;
#pragma unroll
        for (int bj = 0; bj < 2; ++bj) {
            const int col = u.pn * 256 + bj * 128 + wc * 32 + 8 * fq; const int head = col / 96, w = col - head * 96;
            bf16_t* pb = Q + ((size_t)((b * NH + head) * SEQ + s0)) * DQK + w;
#pragma unroll
            for (int ai = 0; ai < 2; ++ai)
#pragma unroll
                for (int m = 0; m < 4; ++m) {
                    const f32x4 v0 = acc[ai][bj][m][0], v1 = acc[ai][bj][m][1];
                    u32x4 o; o.x = cvtpk(v0[0], v0[1]); o.y = cvtpk(v0[2], v0[3]); o.z = cvtpk(v1[0], v1[1]); o.w = cvtpk(v1[2], v1[3]);
                    *(u32x4*)(pb + (ai * 128 + m * 16) * DQK) = o;
                }
            asm volatile("" ::: "memory");
        }
    }
};
struct EpiKV {
    bf16_t* Kn; bf16_t* Vt; const float* rstd;
    __device__ __forceinline__ void operator()(const AccT& acc, const pg8::Unit& u, int wr, int wc, int fr, int fq) const {
        { const int l_ = fresh_lane(); fr = l_ & 15; fq = l_ >> 4; }
        const int row0 = u.pm * 256 + wr * 64 + fr; const int b = row0 >> 12, s0 = row0 & 4095;
        const int w = wc * 32 + 8 * fq;
        const int posfr = (((fr >> 2) & 1) << 3) | (((fr >> 3) & 1) << 2) | (fr & 3);
#pragma unroll
        for (int bj = 0; bj < 2; ++bj) {
            const int head = u.pn * 2 + bj;
            bf16_t* pk = Kn + ((size_t)((b * NH + head) * SEQ + s0)) * DNOPE + w;
            bf16_t* pv = Vt + ((size_t)((b * NH + head) * (SEQ / 32) + (s0 >> 5))) * (DV * 32) + (w - 64) * 32 + posfr;
#pragma unroll
            for (int ai = 0; ai < 2; ++ai)
#pragma unroll
                for (int m = 0; m < 4; ++m) {
                    const float sc = rstd[row0 + ai * 128 + m * 16];
                    const f32x4 a0 = acc[ai][bj][m][0] * sc, a1 = acc[ai][bj][m][1] * sc;
                    if (wc < 2) {
                        u32x4 o; o.x = cvtpk(a0[0], a0[1]); o.y = cvtpk(a0[2], a0[3]); o.z = cvtpk(a1[0], a1[1]); o.w = cvtpk(a1[2], a1[3]);
                        *(u32x4*)(pk + (ai * 128 + m * 16) * DNOPE) = o;
                    } else {
                        bf16_t* p = pv + (ai * 4 + (m >> 1)) * (DV * 32) + 16 * (m & 1);
                        p[0 * 32] = f2bf(a0[0]); p[1 * 32] = f2bf(a0[1]); p[2 * 32] = f2bf(a0[2]); p[3 * 32] = f2bf(a0[3]);
                        p[4 * 32] = f2bf(a1[0]); p[5 * 32] = f2bf(a1[1]); p[6 * 32] = f2bf(a1[2]); p[7 * 32] = f2bf(a1[3]);
                    }
                    asm volatile("" ::: "memory");
                }
        }
    }
};
struct EpiRes {
    const float* base; float* out; const float* gate;
    __device__ __forceinline__ void operator()(const AccT& acc, const pg8::Unit& u, int wr, int wc, int fr, int fq) const {
        { const int l_ = fresh_lane(); fr = l_ & 15; fq = l_ >> 4; }
        const int row0 = u.pm * 256 + wr * 64 + fr; const int b = row0 >> 12;
        const int col0 = u.pn * 256 + wc * 32 + 8 * fq;
        f32x4 g[2][2];
#pragma unroll
        for (int bj = 0; bj < 2; ++bj) { g[bj][0] = *(const f32x4*)(gate + b * 6144 + col0 + bj * 128); g[bj][1] = *(const f32x4*)(gate + b * 6144 + col0 + bj * 128 + 4); }
#pragma unroll
        for (int ai = 0; ai < 2; ++ai) {
            f32x4 xv[4][2][2];
#pragma unroll
            for (int m = 0; m < 4; ++m)
#pragma unroll
                for (int bj = 0; bj < 2; ++bj) { const size_t off = (size_t)(row0 + ai * 128 + m * 16) * DM + col0 + bj * 128; xv[m][bj][0] = __builtin_nontemporal_load((const f32x4*)(base + off)); xv[m][bj][1] = __builtin_nontemporal_load((const f32x4*)(base + off + 4)); }
#pragma unroll
            for (int m = 0; m < 4; ++m)
#pragma unroll
                for (int bj = 0; bj < 2; ++bj) { const size_t off = (size_t)(row0 + ai * 128 + m * 16) * DM + col0 + bj * 128;
                    *(f32x4*)(out + off) = xv[m][bj][0] + g[bj][0] * acc[ai][bj][m][0]; *(f32x4*)(out + off + 4) = xv[m][bj][1] + g[bj][1] * acc[ai][bj][m][1]; }
            asm volatile("" ::: "memory");
        }
    }
};
struct EpiResNorm {
    const float* base; float* out; const float* gate; const float* gfin;
    float* xbuf;
    unsigned* cnt;
    LAS unsigned char* l;
    __device__ __forceinline__ void operator()(AccT& acc, const pg8::Unit& u, int wr, int wc, int fr, int fq) const {
        const int lane = fresh_lane(); fr = lane & 15; fq = lane >> 4;
        const int wid = wr * 4 + wc;
        const int row0 = u.pm * 256 + wr * 64 + fr; const int b = row0 >> 12;
        const int col0 = u.pn * 256 + wc * 32 + 8 * fq;
        LAS float* P = (LAS float*)l; LAS float* S = (LAS float*)(l + 4096); volatile LAS unsigned* flag = (volatile LAS unsigned*)(l + 4096 + 1024);
        float sp[2][4];
        {
            f32x4 g[2][2];
#pragma unroll
            for (int bj = 0; bj < 2; ++bj) { g[bj][0] = *(const f32x4*)(gate + b * 6144 + col0 + bj * 128); g[bj][1] = *(const f32x4*)(gate + b * 6144 + col0 + bj * 128 + 4); }
#pragma unroll
            for (int am = 0; am < 4; ++am) {
                const int ai = am >> 1, mb = (am & 1) * 2;
                f32x4 xv[2][2][2];
#pragma unroll
                for (int m2 = 0; m2 < 2; ++m2)
#pragma unroll
                    for (int bj = 0; bj < 2; ++bj) { const size_t off = (size_t)(row0 + ai * 128 + (mb + m2) * 16) * DM + col0 + bj * 128; xv[m2][bj][0] = *(const f32x4*)(base + off); xv[m2][bj][1] = *(const f32x4*)(base + off + 4); }
#pragma unroll
                for (int m2 = 0; m2 < 2; ++m2) {
                    const int m = mb + m2;
                    float q = 0.f;
#pragma unroll
                    for (int bj = 0; bj < 2; ++bj) {
                        const f32x4 r0 = xv[m2][bj][0] + g[bj][0] * acc[ai][bj][m][0], r1 = xv[m2][bj][1] + g[bj][1] * acc[ai][bj][m][1];
                        acc[ai][bj][m][0] = r0; acc[ai][bj][m][1] = r1;
                        q += (r0[0] * r0[0] + r0[1] * r0[1]) + (r0[2] * r0[2] + r0[3] * r0[3]) + (r1[0] * r1[0] + r1[1] * r1[1]) + (r1[2] * r1[2] + r1[3] * r1[3]);
                    }
                    q += __shfl_xor(q, 16); q += __shfl_xor(q, 32);
                    sp[ai][m] = q;
                }
                asm volatile("" ::: "memory");
            }
        }
        if (fq == 0) {
#pragma unroll
            for (int ai = 0; ai < 2; ++ai)
#pragma unroll
                for (int m = 0; m < 4; ++m) P[(ai * 128 + wr * 64 + m * 16 + fr) * 4 + wc] = sp[ai][m];
        }
        asm volatile("s_waitcnt lgkmcnt(0)" ::: "memory"); __builtin_amdgcn_s_barrier(); asm volatile("" ::: "memory");
        const int prow = wid * 32 + (lane & 31);
        if (lane < 32) {
            const float t = (P[prow * 4 + 0] + P[prow * 4 + 1]) + (P[prow * 4 + 2] + P[prow * 4 + 3]);
            __hip_atomic_store((unsigned*)xbuf + (size_t)(u.pm * 256 + prow) * 4 + u.pn, __float_as_uint(t), __ATOMIC_RELAXED, __HIP_MEMORY_SCOPE_AGENT);
        }
        asm volatile("s_waitcnt vmcnt(0)" ::: "memory");
        if (lane == 0) __hip_atomic_fetch_add(cnt + u.pm, 1u, __ATOMIC_RELAXED, __HIP_MEMORY_SCOPE_AGENT);
        if (wid == 0) {
            unsigned spins = 0;
            while ((unsigned)__builtin_amdgcn_readfirstlane(__hip_atomic_load(cnt + u.pm, __ATOMIC_RELAXED, __HIP_MEMORY_SCOPE_AGENT)) < 32u) { __builtin_amdgcn_s_sleep(2); if (++spins > (1u << 22)) break; }
            __builtin_amdgcn_fence(__ATOMIC_ACQUIRE, "agent");
            if (lane == 0) flag[0] = 1u;
        }
        asm volatile("s_waitcnt vmcnt(0) lgkmcnt(0)" ::: "memory"); __builtin_amdgcn_s_barrier(); asm volatile("" ::: "memory");
        if (lane < 32) {
            const unsigned* slot = (const unsigned*)xbuf + (size_t)(u.pm * 256 + prow) * 4;
            float t = 0.f;
#pragma unroll
            for (int k = 0; k < 4; ++k) t += __uint_as_float(__hip_atomic_load(slot + k, __ATOMIC_RELAXED, __HIP_MEMORY_SCOPE_AGENT));
            S[prow] = rsqrtf(t * (1.f / DM) + EPS);
        }
        asm volatile("s_waitcnt lgkmcnt(0)" ::: "memory"); __builtin_amdgcn_s_barrier(); asm volatile("" ::: "memory");
        f32x4 gf[2][2];
#pragma unroll
        for (int bj = 0; bj < 2; ++bj) { gf[bj][0] = *(const f32x4*)(gfin + col0 + bj * 128); gf[bj][1] = *(const f32x4*)(gfin + col0 + bj * 128 + 4); }
#pragma unroll
        for (int ai = 0; ai < 2; ++ai)
#pragma unroll
            for (int m = 0; m < 4; ++m) {
                const float rs = S[ai * 128 + wr * 64 + m * 16 + fr];
#pragma unroll
                for (int bj = 0; bj < 2; ++bj) { const size_t off = (size_t)(row0 + ai * 128 + m * 16) * DM + col0 + bj * 128;
                    *(f32x4*)(out + off) = acc[ai][bj][m][0] * rs * gf[bj][0]; *(f32x4*)(out + off + 4) = acc[ai][bj][m][1] * rs * gf[bj][1]; }
            }
        asm volatile("s_waitcnt lgkmcnt(0)" ::: "memory");
    }
};
struct EpiGU {
    static constexpr bool PREFETCH = false;
    bf16_t* act;
    __device__ __forceinline__ void operator()(const AccT& acc, const pg8::Unit& u, int wr, int wc, int fr, int fq) const {
        { const int l_ = fresh_lane(); fr = l_ & 15; fq = l_ >> 4; }
        const int odd = fq & 1;
        const int row0 = u.pm * 256 + wr * 64 + fr + 16 * odd;
        const int acol0 = u.pn * 128 + wc * 16 + 4 * (fq & ~1);
#pragma unroll
        for (int ai = 0; ai < 2; ++ai)
#pragma unroll
            for (int mp = 0; mp < 2; ++mp) {
#pragma unroll
                for (int bj = 0; bj < 2; ++bj) {
                    const f32x4 g0 = acc[ai][bj][2 * mp][0], u0 = acc[ai][bj][2 * mp][1], g1 = acc[ai][bj][2 * mp + 1][0], u1 = acc[ai][bj][2 * mp + 1][1];
                    unsigned ax = cvtpk(siluf(g0[0]) * u0[0], siluf(g0[1]) * u0[1]), ay = cvtpk(siluf(g0[2]) * u0[2], siluf(g0[3]) * u0[3]);
                    unsigned bx = cvtpk(siluf(g1[0]) * u1[0], siluf(g1[1]) * u1[1]), by = cvtpk(siluf(g1[2]) * u1[2], siluf(g1[3]) * u1[3]);
                    { auto r = __builtin_amdgcn_permlane16_swap(ax, bx, false, false); ax = r[0]; bx = r[1]; }
                    { auto r = __builtin_amdgcn_permlane16_swap(ay, by, false, false); ay = r[0]; by = r[1]; }
                    u32x4 o; o.x = ax; o.y = ay; o.z = bx; o.w = by;
                    *(u32x4*)(act + (size_t)(row0 + ai * 128 + mp * 32) * DFF + acol0 + bj * 64) = o;
                }
                asm volatile("" ::: "memory");
            }
    }
};

__device__ __forceinline__ int map_row(int mapid, int n) {
    if (mapid == 1) { const int head = n / 96, w = n - head * 96; if (w < 64) return n; const int r = w - 64; const int p = (r < 16) ? 2 * r : 2 * (r - 16) + 1; return head * 96 + 64 + p; }
    if (mapid == 2) return 8 * (n >> 2) + (n & 3);
    if (mapid == 3) return 8 * (n >> 2) + 4 + (n & 3);
    return n;
}
__device__ __forceinline__ void transpose_item(const float* W, int K, int N, int Npad, bf16_t* WT, int mapid, const float* kscale, LAS float* scr, int item, int lane) {
    const int nblk = Npad / 32, kb = item / nblk, nb = item % nblk, k0 = 64 * kb, n0 = 32 * nb;
    const int nn = n0 + (lane & 31);
#pragma unroll
    for (int i = 0; i < 32; ++i) { const int kk = 2 * i + (lane >> 5); float v = 0.f; if (nn < N) { v = __builtin_nontemporal_load(W + (size_t)(k0 + kk) * N + nn); if (kscale) v *= kscale[k0 + kk]; } scr[kk * 33 + (lane & 31)] = v; }
    asm volatile("s_waitcnt lgkmcnt(0)" ::: "memory");
    const int c = lane & 7;
#pragma unroll
    for (int j = 0; j < 4; ++j) { const int n = (lane >> 3) + 8 * j; const LAS float* s = scr + (8 * c) * 33 + n;
        u32x4 o; o.x = cvtpk(s[0 * 33], s[1 * 33]); o.y = cvtpk(s[2 * 33], s[3 * 33]); o.z = cvtpk(s[4 * 33], s[5 * 33]); o.w = cvtpk(s[6 * 33], s[7 * 33]);
        const int nsrc = n0 + n; const int drow = (nsrc < N) ? map_row(mapid, nsrc) : nsrc;
        *(u32x4*)(WT + (size_t)drow * K + k0 + 8 * c) = o; }
    asm volatile("s_waitcnt lgkmcnt(0)" ::: "memory");
}

constexpr int AT_KROW = 208, AT_VROW = 144, AT_KBYTES = 64 * AT_KROW, AT_BUF = AT_KBYTES + 64 * AT_VROW;
__device__ __forceinline__ void attn_unit(LAS unsigned char* lds, const bf16_t* __restrict__ Q, const bf16_t* __restrict__ Kn, const bf16_t* __restrict__ Kr, const bf16_t* __restrict__ Vt,
                                          bf16_t* Y, const float* __restrict__ gout, const float* __restrict__ rstdq, const float* __restrict__ cosT, const float* __restrict__ sinT,
                                          int b, int hd, int qb, int wave, int lane) {
    asm volatile("" : "+v"(lane)); lane &= 63;
    const int r32 = lane & 31, hi = lane >> 5, tid = wave * 64 + lane;
    const int qrow0 = qb * 512 + wave * 64;
    bf16x8 qf[2][6];
#pragma unroll
    for (int i = 0; i < 2; ++i) {
        const int q = qrow0 + 32 * i + r32;
        const bf16_t* Qp = Q + ((size_t)((b * NH + hd) * SEQ + q)) * DQK + 8 * hi;
        const float qsc = rstdq[(size_t)b * SEQ + q] * QSCALE;
#pragma unroll
        for (int d0 = 0; d0 < 6; ++d0) {
            const u32x4 qu = *(const u32x4*)(Qp + 16 * d0);
            float e0 = bflo(qu.x) * qsc, e1 = bfhi(qu.x) * qsc, e2 = bflo(qu.y) * qsc, e3 = bfhi(qu.y) * qsc, e4 = bflo(qu.z) * qsc, e5 = bfhi(qu.z) * qsc, e6 = bflo(qu.w) * qsc, e7 = bfhi(qu.w) * qsc;
            if (d0 >= 4) {
                const int i0 = 8 * (d0 - 4) + 4 * hi;
                const f32x4 c = *(const f32x4*)(cosT + ((size_t)b * SEQ + q) * 16 + i0), sn = *(const f32x4*)(sinT + ((size_t)b * SEQ + q) * 16 + i0);
                const float t0 = e0 * c[0] - e1 * sn[0], t1 = e1 * c[0] + e0 * sn[0], t2 = e2 * c[1] - e3 * sn[1], t3 = e3 * c[1] + e2 * sn[1];
                const float t4 = e4 * c[2] - e5 * sn[2], t5 = e5 * c[2] + e4 * sn[2], t6 = e6 * c[3] - e7 * sn[3], t7 = e7 * c[3] + e6 * sn[3];
                e0 = t0; e1 = t1; e2 = t2; e3 = t3; e4 = t4; e5 = t5; e6 = t6; e7 = t7;
            }
            u32x4 o; o.x = cvtpk(e0, e1); o.y = cvtpk(e2, e3); o.z = cvtpk(e4, e5); o.w = cvtpk(e6, e7);
            qf[i][d0] = __builtin_bit_cast(bf16x8, o);
        }
    }
    const int NTL = 8 * (qb + 1), tmax = qrow0 >> 6;
    const bf16_t* gK = Kn + ((size_t)((b * NH + hd) * SEQ + (tid >> 3))) * DNOPE + (tid & 7) * 8;
    const bf16_t* gKr = Kr + ((size_t)(b * SEQ + (tid >> 2))) * DROPE + (tid & 3) * 8;
    const bf16_t* gV = Vt + (((size_t)(b * NH + hd) * (SEQ / 32) + (tid >> 8)) * DV + ((tid >> 2) & 63)) * 32 + (tid & 3) * 8;
    const unsigned lK = (tid >> 3) * AT_KROW + (tid & 7) * 16, lKr = (tid >> 2) * AT_KROW + 128 + (tid & 3) * 16;
    const unsigned lV = AT_KBYTES + ((tid >> 2) & 63) * AT_VROW + (tid >> 8) * 64 + (tid & 3) * 16;
    u32x4 sk, skr = {0u, 0u, 0u, 0u}, sv;
    sk = *(const u32x4*)gK; if (tid < 256) skr = *(const u32x4*)gKr; sv = *(const u32x4*)gV;
    *(LAS u32x4*)(lds + lK) = sk; if (tid < 256) *(LAS u32x4*)(lds + lKr) = skr; *(LAS u32x4*)(lds + lV) = sv;
    __syncthreads();
    f32x16 o[2][2];
#pragma unroll
    for (int i = 0; i < 2; ++i)
#pragma unroll
        for (int r = 0; r < 16; ++r) { o[i][0][r] = 0.f; o[i][1][r] = 0.f; }
    constexpr float ATT_THR = 8.f;
    float mref[2] = {0.f, 0.f}, lrun[2] = {0.f, 0.f};
#pragma unroll 1
    for (int t = 0; t < NTL; ++t) {
        const unsigned cur = (t & 1) * AT_BUF, nxt = AT_BUF - cur;
        if (t + 1 < NTL) {
            sk = *(const u32x4*)(gK + (size_t)(t + 1) * 64 * DNOPE); if (tid < 256) skr = *(const u32x4*)(gKr + (size_t)(t + 1) * 64 * DROPE);
            sv = *(const u32x4*)(gV + (size_t)(t + 1) * 2 * DV * 32);
        }
        if (t <= tmax) {
            const LAS unsigned char* kb = lds + cur + r32 * AT_KROW + hi * 16;
            f32x16 s[2][2];
#pragma unroll
            for (int i = 0; i < 2; ++i)
#pragma unroll
                for (int r = 0; r < 16; ++r) { s[i][0][r] = 0.f; s[i][1][r] = 0.f; }
#pragma unroll
            for (int d0 = 0; d0 < 6; ++d0) {
                const bf16x8 k0 = *(const LAS bf16x8*)(kb + d0 * 32), k1 = *(const LAS bf16x8*)(kb + 32 * AT_KROW + d0 * 32);
                s[0][0] = __builtin_amdgcn_mfma_f32_32x32x16_bf16(k0, qf[0][d0], s[0][0], 0, 0, 0);
                s[0][1] = __builtin_amdgcn_mfma_f32_32x32x16_bf16(k1, qf[0][d0], s[0][1], 0, 0, 0);
                s[1][0] = __builtin_amdgcn_mfma_f32_32x32x16_bf16(k0, qf[1][d0], s[1][0], 0, 0, 0);
                s[1][1] = __builtin_amdgcn_mfma_f32_32x32x16_bf16(k1, qf[1][d0], s[1][1], 0, 0, 0);
            }
            u32x4 p[2][4];
#pragma unroll
            for (int i = 0; i < 2; ++i) {
                f32x16 s0 = s[i][0] - mref[i], s1 = s[i][1] - mref[i];
                if (t == tmax) {
                    const int qrel = 32 * i + r32;
#pragma unroll
                    for (int r = 0; r < 16; ++r) { const int key = crow(r, hi); if (key > qrel) s0[r] = -INFINITY; if (key + 32 > qrel) s1[r] = -INFINITY; }
                }
                float mx = fmaxf(fmaxf(s0[0], s1[0]), fmaxf(s0[1], s1[1]));
#pragma unroll
                for (int r = 2; r < 16; r += 2) mx = fmaxf(fmaxf(mx, fmaxf(s0[r], s1[r])), fmaxf(s0[r + 1], s1[r + 1]));
                mx = fmaxf(mx, __shfl_xor(mx, 32));
                if (t == 0 || __any(mx > ATT_THR)) {
                    const float dl = (t == 0) ? mx : fmaxf(mx, 0.f);
                    mref[i] += dl;
                    s0 = s0 - dl; s1 = s1 - dl;
                    const float alpha = __builtin_amdgcn_exp2f(-dl);
                    lrun[i] *= alpha; o[i][0] = o[i][0] * alpha; o[i][1] = o[i][1] * alpha;
                }
#pragma unroll
                for (int r = 0; r < 16; ++r) { s0[r] = __builtin_amdgcn_exp2f(s0[r]); s1[r] = __builtin_amdgcn_exp2f(s1[r]); }
                {
                    const f32x16 ts = s0 + s1;
                    lrun[i] += ((ts[0] + ts[1]) + (ts[2] + ts[3])) + ((ts[4] + ts[5]) + (ts[6] + ts[7])) + ((ts[8] + ts[9]) + (ts[10] + ts[11])) + ((ts[12] + ts[13]) + (ts[14] + ts[15]));
                }
                p[i][0].x = cvtpk(s0[0], s0[1]); p[i][0].y = cvtpk(s0[2], s0[3]); p[i][0].z = cvtpk(s0[4], s0[5]); p[i][0].w = cvtpk(s0[6], s0[7]);
                p[i][1].x = cvtpk(s0[8], s0[9]); p[i][1].y = cvtpk(s0[10], s0[11]); p[i][1].z = cvtpk(s0[12], s0[13]); p[i][1].w = cvtpk(s0[14], s0[15]);
                p[i][2].x = cvtpk(s1[0], s1[1]); p[i][2].y = cvtpk(s1[2], s1[3]); p[i][2].z = cvtpk(s1[4], s1[5]); p[i][2].w = cvtpk(s1[6], s1[7]);
                p[i][3].x = cvtpk(s1[8], s1[9]); p[i][3].y = cvtpk(s1[10], s1[11]); p[i][3].z = cvtpk(s1[12], s1[13]); p[i][3].w = cvtpk(s1[14], s1[15]);
            }
            const LAS unsigned char* vb = lds + cur + AT_KBYTES + r32 * AT_VROW + hi * 16;
#pragma unroll
            for (int kk = 0; kk < 4; ++kk) {
                const bf16x8 v0 = *(const LAS bf16x8*)(vb + kk * 32), v1 = *(const LAS bf16x8*)(vb + 32 * AT_VROW + kk * 32);
                const bf16x8 pf0 = __builtin_bit_cast(bf16x8, p[0][kk]), pf1 = __builtin_bit_cast(bf16x8, p[1][kk]);
                o[0][0] = __builtin_amdgcn_mfma_f32_32x32x16_bf16(v0, pf0, o[0][0], 0, 0, 0);
                o[0][1] = __builtin_amdgcn_mfma_f32_32x32x16_bf16(v1, pf0, o[0][1], 0, 0, 0);
                o[1][0] = __builtin_amdgcn_mfma_f32_32x32x16_bf16(v0, pf1, o[1][0], 0, 0, 0);
                o[1][1] = __builtin_amdgcn_mfma_f32_32x32x16_bf16(v1, pf1, o[1][1], 0, 0, 0);
            }
        }
        if (t + 1 < NTL) { *(LAS u32x4*)(lds + nxt + lK) = sk; if (tid < 256) *(LAS u32x4*)(lds + nxt + lKr) = skr; *(LAS u32x4*)(lds + nxt + lV) = sv; }
        __syncthreads();
    }
#pragma unroll
    for (int i = 0; i < 2; ++i) {
        const int q = qrow0 + 32 * i + r32;
        const float ltot = lrun[i] + __shfl_xor(lrun[i], 32);
        const float inv = 1.f / ltot;
        float ssq = 0.f;
#pragma unroll
        for (int r = 0; r < 16; ++r) { o[i][0][r] *= inv; o[i][1][r] *= inv; ssq += o[i][0][r] * o[i][0][r] + o[i][1][r] * o[i][1][r]; }
        ssq += __shfl_xor(ssq, 32);
        const float rs = rsqrtf(ssq * (1.f / DV) + EPS);
        bf16_t* yp = Y + (size_t)(b * SEQ + q) * DMIX + hd * DV + 4 * hi;
        const float* gp = gout + hd * DV + 4 * hi;
#pragma unroll
        for (int g = 0; g < 4; ++g) {
            const f32x4 g0 = *(const f32x4*)(gp + 8 * g), g1 = *(const f32x4*)(gp + 32 + 8 * g);
            u32x2 w0, w1;
            w0.x = cvtpk(o[i][0][4 * g] * rs * g0[0], o[i][0][4 * g + 1] * rs * g0[1]); w0.y = cvtpk(o[i][0][4 * g + 2] * rs * g0[2], o[i][0][4 * g + 3] * rs * g0[3]);
            w1.x = cvtpk(o[i][1][4 * g] * rs * g1[0], o[i][1][4 * g + 1] * rs * g1[1]); w1.y = cvtpk(o[i][1][4 * g + 2] * rs * g1[2], o[i][1][4 * g + 3] * rs * g1[3]);
            *(u32x2*)(yp + 8 * g) = w0; *(u32x2*)(yp + 32 + 8 * g) = w1;
        }
    }
}

__device__ __forceinline__ float wave_incl_scan(float v, int lane) {
#pragma unroll
    for (int o = 1; o < 64; o <<= 1) { const float t = __shfl_up(v, o); if (lane >= o) v += t; }
    return v;
}
__device__ __forceinline__ void mlstm_chunk_state(int ch, const bf16_t* __restrict__ Z, const bf16_t* __restrict__ Km, const float* __restrict__ gates,
                                                  float* dC, float* dn, float* mloc, float* btot, int lane) {
    asm volatile("" : "+v"(lane)); lane &= 63;
    const int c = ch & 63, hh = (ch >> 6) & 3, b = ch >> 8;
    const int r32 = lane & 31, hi = lane >> 5;
    const size_t row0 = (size_t)b * SEQ + c * CHUNK;
    const float gi = gates[(row0 + lane) * 8 + hh], gf = gates[(row0 + lane) * 8 + 4 + hh];
    const float lf = logsigmoidf_(gf);
    const float bcum = wave_incl_scan(lf, lane);
    const float bt = __shfl(bcum, 63);
    const float g = bt - bcum + gi;
    const float ml = wave_max(g);
    const float wgt = __expf(g - ml);
    f32x16 acc[4][2];
#pragma unroll
    for (int vb = 0; vb < 4; ++vb)
#pragma unroll
        for (int kb = 0; kb < 2; ++kb)
#pragma unroll
            for (int r = 0; r < 16; ++r) acc[vb][kb][r] = 0.f;
    float dnp[2] = {0.f, 0.f};
    const bf16_t* Vp = Z + row0 * DINP + ZV + hh * MDV + r32;
    const bf16_t* Kp = Km + ((size_t)((b * MH + hh) * SEQ + c * CHUNK)) * MDK + r32;
#pragma unroll 2
    for (int ks = 0; ks < 4; ++ks) {
        const int l0 = 16 * ks + 8 * hi;
        float w[8];
#pragma unroll
        for (int j = 0; j < 8; ++j) w[j] = __shfl(wgt, l0 + j);
        bf16x8 bfr[2];
#pragma unroll
        for (int kb = 0; kb < 2; ++kb) {
            float kv[8];
#pragma unroll
            for (int j = 0; j < 8; ++j) { kv[j] = bf2f(Kp[(size_t)(l0 + j) * MDK + 32 * kb]) * w[j]; dnp[kb] += kv[j]; }
            u32x4 p; p.x = cvtpk(kv[0], kv[1]); p.y = cvtpk(kv[2], kv[3]); p.z = cvtpk(kv[4], kv[5]); p.w = cvtpk(kv[6], kv[7]);
            bfr[kb] = __builtin_bit_cast(bf16x8, p);
        }
#pragma unroll
        for (int vb = 0; vb < 4; ++vb) {
            bf16x8 af;
#pragma unroll
            for (int j = 0; j < 8; ++j) af[j] = (short)Vp[(size_t)(l0 + j) * DINP + 32 * vb];
            acc[vb][0] = __builtin_amdgcn_mfma_f32_32x32x16_bf16(af, bfr[0], acc[vb][0], 0, 0, 0);
            acc[vb][1] = __builtin_amdgcn_mfma_f32_32x32x16_bf16(af, bfr[1], acc[vb][1], 0, 0, 0);
        }
    }
    float* dCp = dC + (size_t)ch * (MDV * MDK);
#pragma unroll
    for (int vb = 0; vb < 4; ++vb)
#pragma unroll
        for (int kb = 0; kb < 2; ++kb)
#pragma unroll
            for (int r = 0; r < 16; ++r) dCp[(32 * vb + crow(r, hi)) * MDK + 32 * kb + r32] = acc[vb][kb][r];
#pragma unroll
    for (int kb = 0; kb < 2; ++kb) { const float t = dnp[kb] + __shfl_xor(dnp[kb], 32); if (hi == 0) dn[(size_t)ch * MDK + 32 * kb + r32] = t; }
    if (lane == 0) { mloc[ch] = ml; btot[ch] = bt; }
}

__device__ __forceinline__ float wave_incl_scan_max(float v, int lane) {
#pragma unroll
    for (int o = 1; o < 64; o <<= 1) { const float t = __shfl_up(v, o); if (lane >= o) v = fmaxf(v, t); }
    return v;
}
__device__ __forceinline__ void mlstm_chunk_out(int ch, const bf16_t* __restrict__ Z, const bf16_t* __restrict__ Qm, const bf16_t* __restrict__ Km, const float* __restrict__ gates,
                                                const bf16_t* __restrict__ C0, const float* __restrict__ n0, const float* __restrict__ m0p, const float* __restrict__ gout,
                                                bf16_t* Y, int lane) {
    asm volatile("" : "+v"(lane)); lane &= 63;
    const int c = ch & 63, hh = (ch >> 6) & 3, b = ch >> 8;
    int r32 = lane & 31, hi = lane >> 5;
    const size_t row0 = (size_t)b * SEQ + c * CHUNK;
    const float gi = gates[(row0 + lane) * 8 + hh], gf = gates[(row0 + lane) * 8 + 4 + hh];
    const float lf = logsigmoidf_(gf);
    const float bcum = wave_incl_scan(lf, lane);
    const float uu = gi - bcum;
    const float pmax = wave_incl_scan_max(uu, lane);
    const float m0 = m0p[ch];
    const bf16_t* Qb = Qm + ((size_t)((b * MH + hh) * SEQ + c * CHUNK)) * MDK;
    const bf16_t* Kb = Km + ((size_t)((b * MH + hh) * SEQ + c * CHUNK)) * MDK;
    const bf16_t* Vp = Z + row0 * DINP + ZV + hh * MDV + r32;
    const bf16_t* C0p = C0 + (size_t)ch * (MDV * MDK);
    const float* n0p = n0 + (size_t)ch * MDK;
#pragma unroll 1
    for (int tb = 0; tb < 2; ++tb) {
        asm volatile("" : "+v"(r32), "+v"(hi)); r32 &= 31; hi &= 1;
        const int t = 32 * tb + r32;
        const float bt_t = __shfl(bcum, t), pm_t = __shfl(pmax, t);
        const float mt = bt_t + fmaxf(m0, pm_t);
        const float inter = __expf(bt_t + m0 - mt);
        const float dbase = bt_t - mt;
        bf16x8 qf[4];
#pragma unroll
        for (int d0 = 0; d0 < 4; ++d0) qf[d0] = *(const bf16x8*)(Qb + (size_t)t * MDK + 16 * d0 + 8 * hi);
        float dsum = 0.f;
        bf16x8 pf[2][2];
#pragma unroll
        for (int sb = 0; sb < 2; ++sb) {
            f32x16 sT;
#pragma unroll
            for (int r = 0; r < 16; ++r) sT[r] = 0.f;
            if (sb <= tb) {
#pragma unroll
                for (int d0 = 0; d0 < 4; ++d0) {
                    const bf16x8 kfr = *(const bf16x8*)(Kb + (size_t)(32 * sb + r32) * MDK + 16 * d0 + 8 * hi);
                    sT = __builtin_amdgcn_mfma_f32_32x32x16_bf16(kfr, qf[d0], sT, 0, 0, 0);
                }
            }
            float sc[16];
#pragma unroll
            for (int r = 0; r < 16; ++r) {
                const int s = 32 * sb + crow(r, hi);
                const float us = __shfl(uu, s);
                const float d = (s <= t) ? __expf(dbase + us) : 0.f;
                sc[r] = sT[r] * d; dsum += sc[r];
            }
            u32x4 p0, p1;
            p0.x = cvtpk(sc[0], sc[1]); p0.y = cvtpk(sc[2], sc[3]); p0.z = cvtpk(sc[4], sc[5]); p0.w = cvtpk(sc[6], sc[7]);
            p1.x = cvtpk(sc[8], sc[9]); p1.y = cvtpk(sc[10], sc[11]); p1.z = cvtpk(sc[12], sc[13]); p1.w = cvtpk(sc[14], sc[15]);
            pf[sb][0] = __builtin_bit_cast(bf16x8, p0); pf[sb][1] = __builtin_bit_cast(bf16x8, p1);
        }
        dsum += __shfl_xor(dsum, 32);
        float qn = 0.f; bf16x8 qs[4];
#pragma unroll
        for (int d0 = 0; d0 < 4; ++d0) {
            const f32x4 na = *(const f32x4*)(n0p + 16 * d0 + 8 * hi), nb = *(const f32x4*)(n0p + 16 * d0 + 8 * hi + 4);
            const u32x4 qu = __builtin_bit_cast(u32x4, qf[d0]);
            const float q0 = bflo(qu.x), q1 = bfhi(qu.x), q2 = bflo(qu.y), q3 = bfhi(qu.y), q4 = bflo(qu.z), q5 = bfhi(qu.z), q6 = bflo(qu.w), q7 = bfhi(qu.w);
            qn += q0 * na[0] + q1 * na[1] + q2 * na[2] + q3 * na[3] + q4 * nb[0] + q5 * nb[1] + q6 * nb[2] + q7 * nb[3];
            u32x4 o; o.x = cvtpk(q0 * inter, q1 * inter); o.y = cvtpk(q2 * inter, q3 * inter); o.z = cvtpk(q4 * inter, q5 * inter); o.w = cvtpk(q6 * inter, q7 * inter);
            qs[d0] = __builtin_bit_cast(bf16x8, o);
        }
        qn += __shfl_xor(qn, 32);
        const float den = dsum + inter * qn;
        const float rden = 1.f / fmaxf(fabsf(den), __expf(-mt));
        const bf16_t* zo = Z + (row0 + t) * DINP + ZO + hh * MDV + 4 * hi;
        f32x16 nm[4];
        float ssq = 0.f;
#pragma unroll
        for (int vb = 0; vb < 4; ++vb) {
#pragma unroll
            for (int r = 0; r < 16; ++r) nm[vb][r] = 0.f;
#pragma unroll
            for (int d0 = 0; d0 < 4; ++d0) {
                const bf16x8 cf = *(const bf16x8*)(C0p + (size_t)(32 * vb + r32) * MDK + 16 * d0 + 8 * hi);
                nm[vb] = __builtin_amdgcn_mfma_f32_32x32x16_bf16(cf, qs[d0], nm[vb], 0, 0, 0);
            }
#pragma unroll
            for (int sb = 0; sb < 2; ++sb) {
                if (sb <= tb) {
#pragma unroll
                    for (int ks = 0; ks < 2; ++ks) {
                        bf16x8 vf;
#pragma unroll
                        for (int j = 0; j < 8; ++j) { const int s = 32 * sb + 16 * ks + 8 * (j >> 2) + 4 * hi + (j & 3); vf[j] = (short)Vp[(size_t)s * DINP + 32 * vb]; }
                        nm[vb] = __builtin_amdgcn_mfma_f32_32x32x16_bf16(vf, pf[sb][ks], nm[vb], 0, 0, 0);
                    }
                }
            }
#pragma unroll
            for (int g = 0; g < 4; ++g) {
                const u32x2 ou = *(const u32x2*)(zo + 32 * vb + 8 * g);
                const float o0 = sigmoidf_(bflo(ou.x)), o1 = sigmoidf_(bfhi(ou.x)), o2 = sigmoidf_(bflo(ou.y)), o3 = sigmoidf_(bfhi(ou.y));
                nm[vb][4 * g] *= rden * o0; nm[vb][4 * g + 1] *= rden * o1; nm[vb][4 * g + 2] *= rden * o2; nm[vb][4 * g + 3] *= rden * o3;
                ssq += nm[vb][4 * g] * nm[vb][4 * g] + nm[vb][4 * g + 1] * nm[vb][4 * g + 1] + nm[vb][4 * g + 2] * nm[vb][4 * g + 2] + nm[vb][4 * g + 3] * nm[vb][4 * g + 3];
            }
            asm volatile("" ::: "memory");
        }
        ssq += __shfl_xor(ssq, 32);
        const float rs = rsqrtf(ssq * (1.f / MDV) + EPS);
        bf16_t* yp = Y + (row0 + t) * DMIX + 512 + hh * MDV + 4 * hi;
        const float* gp = gout + hh * MDV + 4 * hi;
#pragma unroll
        for (int vb = 0; vb < 4; ++vb)
#pragma unroll
            for (int g = 0; g < 4; ++g) {
                const f32x4 gg = *(const f32x4*)(gp + 32 * vb + 8 * g);
                u32x2 w; w.x = cvtpk(nm[vb][4 * g] * rs * gg[0], nm[vb][4 * g + 1] * rs * gg[1]); w.y = cvtpk(nm[vb][4 * g + 2] * rs * gg[2], nm[vb][4 * g + 3] * rs * gg[3]);
                *(u32x2*)(yp + 32 * vb + 8 * g) = w;
            }
    }
}


#define XB_TMO      128
#define XB_XCNT(j)  (256  + 64 * (j))
#define XB_XSUB(j)  (1280 + 64 * (j))
#define XB_XGEN(j)  (2304 + 64 * (j))
#define XB_TOP      3328
#define XB_TOPGEN   3392
#define XCD_BAR_WORDS 3456
#define XB_SPIN_CAP (1u << 22)
__device__ __forceinline__ unsigned xb_ld(unsigned* p)              { return __hip_atomic_load(p, __ATOMIC_RELAXED, __HIP_MEMORY_SCOPE_AGENT); }
__device__ __forceinline__ unsigned xb_add(unsigned* p, unsigned v) { return __hip_atomic_fetch_add(p, v, __ATOMIC_RELAXED, __HIP_MEMORY_SCOPE_AGENT); }
__device__ __forceinline__ unsigned xb_xcc_id() { return (unsigned)__builtin_amdgcn_s_getreg((3 << 11) | 20) & 0xFu; }
#define XB_SPIN(cond, bar) do { unsigned _sp = 0; while (cond) { __builtin_amdgcn_s_sleep(1); \
    if ((++_sp & 255u) == 0u) { if (xb_ld(&(bar)[XB_TMO])) break; if (_sp > XB_SPIN_CAP) { atomicAdd(&(bar)[XB_TMO], 1u); break; } } } } while (0)
struct XcdBarrier { unsigned* bar; unsigned x; volatile LAS unsigned* st; };
__device__ __forceinline__ XcdBarrier xcd_barrier_post(unsigned* bar, volatile LAS unsigned* st) {
    XcdBarrier b; b.bar = bar; b.x = xb_xcc_id(); b.st = st;
    if (threadIdx.x == 0) (void)xb_add(&bar[XB_XCNT(b.x)], 1u);
    return b;
}
__device__ __forceinline__ void xcd_barrier_complete(unsigned* bar, unsigned x, unsigned& nloc, unsigned& nx) {
    const unsigned G = gridDim.x * gridDim.y * gridDim.z;
    unsigned sum, cnt, mine, sp = 0u;
    for (;;) {
        sum = 0u; cnt = 0u; mine = 0u;
#pragma unroll
        for (unsigned j = 0; j < 16; ++j) { const unsigned c = xb_ld(&bar[XB_XCNT(j)]); sum += c; cnt += (c > 0u) ? 1u : 0u; mine = (j == x) ? c : mine; }
        if (sum == G) break;
        __builtin_amdgcn_s_sleep(1);
        if ((++sp & 255u) == 0u) { if (xb_ld(&bar[XB_TMO])) break; if (sp > XB_SPIN_CAP) { atomicAdd(&bar[XB_TMO], 1u); break; } }
    }
    nloc = mine > 0u ? mine : 1u; nx = cnt > 0u ? cnt : 1u;
}
__device__ __forceinline__ void xcd_barrier(const XcdBarrier& b) {
    asm volatile("s_waitcnt vmcnt(0)" ::: "memory");
    __syncthreads();
    if (threadIdx.x == 0) {
        unsigned* bar = b.bar;
        __builtin_amdgcn_s_waitcnt(0);
        unsigned nloc = b.st[0], nx = b.st[1];
        if (nloc == 0u) { xcd_barrier_complete(bar, b.x, nloc, nx); b.st[0] = nloc; b.st[1] = nx; }
        const unsigned old = xb_add(&bar[XB_XSUB(b.x)], 1u);
        const unsigned gen = old / nloc;
        if (old + 1u == (gen + 1u) * nloc) {
            __builtin_amdgcn_fence(__ATOMIC_RELEASE, "agent");
            asm volatile("s_waitcnt vmcnt(0)" ::: "memory");
            const unsigned og = xb_add(&bar[XB_TOP], 1u);
            const unsigned tg = og / nx;
            if (og + 1u == (tg + 1u) * nx) xb_add(&bar[XB_TOPGEN], 1u);
            else XB_SPIN(xb_ld(&bar[XB_TOPGEN]) == tg, bar);
            __builtin_amdgcn_fence(__ATOMIC_ACQUIRE, "agent");
            xb_add(&bar[XB_XGEN(b.x)], 1u);
            asm volatile("s_waitcnt vmcnt(0)" ::: "memory");
        } else {
            XB_SPIN(xb_ld(&bar[XB_XGEN(b.x)]) == gen, bar);
            __builtin_amdgcn_fence(__ATOMIC_ACQUIRE, "agent");
            asm volatile("s_waitcnt vmcnt(0)" ::: "memory");
        }
    }
    __syncthreads();
}

struct Args { const void* in[22]; float* out; unsigned char* ws; };
#ifndef PHASE_MASK
#define PHASE_MASK 0xFFFF
#endif
#define PH(n) (((PHASE_MASK) >> (n)) & 1)
#ifndef FUSE_FINAL_NORM
#define FUSE_FINAL_NORM 0
#endif
#ifndef DUP_MASK
#define DUP_MASK 0
#endif
#define DUP(n) (1 + (((DUP_MASK) >> (n)) & 1))
constexpr int LDS_BYTES = 147456;

__global__ void __launch_bounds__(512, 2) fwd_megakernel(Args a) {
    extern __shared__ __attribute__((aligned(16))) unsigned char lds_raw[];
    cg::grid_group grid = cg::this_grid();
    LAS unsigned char* lds = (LAS unsigned char*)lds_raw;
    const int wave = __builtin_amdgcn_readfirstlane((int)threadIdx.x >> 6);
    const int G = gridDim.x, bx = blockIdx.x;
    const int gw = bx * 8 + wave, NGW = G * 8;
    const int NT = G * 512;
#define FRESH_IDS() int lane = fresh_lane(); const int tid = wave * 64 + lane; const int gtid = bx * 512 + tid; (void)tid; (void)gtid

    const float* x = (const float*)a.in[0]; const float* cvec = (const float*)a.in[1]; const int* positions = (const int*)a.in[2];
    const float* w_ada = (const float*)a.in[3]; const float* b_ada = (const float*)a.in[4]; const float* g_mix = (const float*)a.in[5];
    const float* w_in = (const float*)a.in[6]; const float* g_q = (const float*)a.in[7]; const float* w_uq = (const float*)a.in[8];
    const float* g_kv = (const float*)a.in[9]; const float* w_ukv = (const float*)a.in[10]; const float* conv_w = (const float*)a.in[11];
    const float* conv_b = (const float*)a.in[12]; const float* b_gates = (const float*)a.in[13]; const float* g_out_mla = (const float*)a.in[14];
    const float* g_out_mlstm = (const float*)a.in[15]; const float* w_out = (const float*)a.in[16]; const float* g_ffn = (const float*)a.in[17];
    const float* w_gate = (const float*)a.in[18]; const float* w_up = (const float*)a.in[19]; const float* w_down = (const float*)a.in[20];
    const float* g_final = (const float*)a.in[21];
    float* out = a.out; unsigned char* ws = a.ws;
    float* mod = (float*)(ws + WS_MOD); float* cosT = (float*)(ws + WS_COS); float* sinT = (float*)(ws + WS_SIN);
    float* rstdq = (float*)(ws + WS_RSTDQ); float* rstdkv = (float*)(ws + WS_RSTDKV); float* gates = (float*)(ws + WS_GATES);
    float* mloc = (float*)(ws + WS_MLOC); float* btot = (float*)(ws + WS_BTOT); float* m0buf = (float*)(ws + WS_M0);
    float* dn = (float*)(ws + WS_DN); float* n0buf = (float*)(ws + WS_N0);
    bf16_t* Bin = (bf16_t*)(ws + WS_BIN); bf16_t* Bq = (bf16_t*)(ws + WS_BQ); bf16_t* Bkv = (bf16_t*)(ws + WS_BKV); bf16_t* Bout = (bf16_t*)(ws + WS_BOUT);
    bf16_t* Bgu = (bf16_t*)(ws + WS_BGU); bf16_t* Bd = (bf16_t*)(ws + WS_BD); bf16_t* Krope = (bf16_t*)(ws + WS_KROPE);
    bf16_t* HN = (bf16_t*)(ws + WS_HN); bf16_t* Z = (bf16_t*)(ws + WS_Z); bf16_t* Qb = (bf16_t*)(ws + WS_Q); bf16_t* Kn = (bf16_t*)(ws + WS_KN);
    bf16_t* Vt = (bf16_t*)(ws + WS_VT); bf16_t* Qm = (bf16_t*)(ws + WS_QM); bf16_t* Km = (bf16_t*)(ws + WS_KM);
    float* dC = (float*)(ws + WS_DC); bf16_t* C0 = (bf16_t*)(ws + WS_C0); bf16_t* ACT = (bf16_t*)(ws + WS_ACT);

    unsigned* barw = (unsigned*)(ws + WS_BARW);
    volatile LAS unsigned* bst = (volatile LAS unsigned*)(lds + 131072 + 512);
    if (threadIdx.x < 2) bst[threadIdx.x] = 0u;
    __syncthreads();
    if (G == 0x7fffffff) grid.sync();
    const XcdBarrier xbar = xcd_barrier_post(barw, bst);
    if constexpr (PH(0)) _Pragma("unroll") for (int rep_ = 0; rep_ < DUP(0); ++rep_) {
        FRESH_IDS();
        LAS float* sc = (LAS float*)lds;
        LAS float* part = (LAS float*)(lds + 32768);
        if (bx < 192) {
            for (int i = tid; i < NB * DM; i += 512) sc[i] = siluf(cvec[i]);
            __syncthreads();
            const int col = tid & 31, ks = tid >> 5, n0 = 32 * bx;
            float acc[8];
#pragma unroll
            for (int b = 0; b < 8; ++b) acc[b] = 0.f;
#pragma unroll 16
            for (int kk = 0; kk < 64; ++kk) { const int k = ks * 64 + kk; const float w = __builtin_nontemporal_load(w_ada + (size_t)k * 6144 + n0 + col);
#pragma unroll
                for (int b = 0; b < 8; ++b) acc[b] += sc[b * DM + k] * w; }
#pragma unroll
            for (int b = 0; b < 8; ++b) part[(ks * 8 + b) * 32 + col] = acc[b];
            __syncthreads();
            if (tid < 256) { const int b = tid >> 5; float s = b_ada[n0 + col];
#pragma unroll
                for (int k2 = 0; k2 < 16; ++k2) s += part[(k2 * 8 + b) * 32 + col];
                mod[b * 6144 + n0 + col] = s; }
            __syncthreads();
        }
        if (gtid < 256) ((unsigned*)(ws + WS_PCNT))[gtid] = 0u;
        for (int idx = gtid; idx < MROWS * 16; idx += NT) {
            const int row = idx >> 4, i = idx & 15;
            const float inv = powf(10000.f, -(float)i / 16.f);
            const float ang = (float)positions[row] * inv;
            float sn, cs; sincosf(ang, &sn, &cs);
            cosT[idx] = cs; sinT[idx] = sn;
        }
        LAS float* scr = (LAS float*)(lds + wave * 16384);
        constexpr int I_IN = 16 * 72, I_Q = 6 * 24, I_KV = 4 * 32, I_OUT = 16 * 32, I_G = 16 * 88, I_D = 44 * 32;
        constexpr int NITEMS = I_IN + I_Q + I_KV + I_OUT + 2 * I_G + I_D;
        for (int it = gw; it < NITEMS; it += NGW) {
            int r = it;
            if (r < I_IN) { transpose_item(w_in, 1024, DIN, DINP, Bin, 0, nullptr, scr, r, lane); continue; } r -= I_IN;
            if (r < I_Q) { transpose_item(w_uq, QRANK, 768, 768, Bq, 1, g_q, scr, r, lane); continue; } r -= I_Q;
            if (r < I_KV) { transpose_item(w_ukv, KVRANK, 1024, 1024, Bkv, 0, g_kv, scr, r, lane); continue; } r -= I_KV;
            if (r < I_OUT) { transpose_item(w_out, 1024, 1024, 1024, Bout, 0, nullptr, scr, r, lane); continue; } r -= I_OUT;
            if (r < I_G) { transpose_item(w_gate, 1024, DFF, DFF, Bgu, 2, nullptr, scr, r, lane); continue; } r -= I_G;
            if (r < I_G) { transpose_item(w_up, 1024, DFF, DFF, Bgu, 3, nullptr, scr, r, lane); continue; } r -= I_G;
            transpose_item(w_down, DFF, 1024, 1024, Bd, 0, nullptr, scr, r, lane);
        }
        if constexpr (DUP(0) == 2) __syncthreads();
    }
    xcd_barrier(xbar);

    if constexpr (PH(1)) _Pragma("unroll") for (int rep_ = 0; rep_ < DUP(1); ++rep_) { FRESH_IDS(); for (int row = gw; row < MROWS; row += NGW) {
        const int b = row >> 12;
        const f32x4* xr = (const f32x4*)(x + (size_t)row * DM) + lane;
        f32x4 v[4]; float s = 0.f;
#pragma unroll
        for (int j = 0; j < 4; ++j) { v[j] = __builtin_nontemporal_load(xr + 64 * j); s += v[j][0] * v[j][0] + v[j][1] * v[j][1] + v[j][2] * v[j][2] + v[j][3] * v[j][3]; }
        const float rstd = rsqrtf(wave_sum(s) * (1.f / DM) + EPS);
        unsigned long long* o8 = (unsigned long long*)(HN + (size_t)row * DM) + lane;
#pragma unroll
        for (int j = 0; j < 4; ++j) {
            const int col = 4 * lane + 256 * j;
            const f32x4 g = *(const f32x4*)(g_mix + col), sh = *(const f32x4*)(mod + b * 6144 + col), sc = *(const f32x4*)(mod + b * 6144 + 1024 + col);
            const f32x4 h = (v[j] * rstd * g) * (sc + 1.f) + sh;
            o8[64 * j] = (unsigned long long)cvtpk(h[0], h[1]) | ((unsigned long long)cvtpk(h[2], h[3]) << 32);
        }
    } }
    xcd_barrier(xbar);

    if constexpr (PH(2)) _Pragma("unroll") for (int rep_ = 0; rep_ < DUP(2); ++rep_) {
        pg8::Gemm g{HN, Bin, MROWS, DINP, 1024, 1024}; pg8::StaticOrder S; S.init(MROWS, DINP, G, bx);
        EpiIn E{Z, gates, b_gates};
        pg8::gemm_phase<EpiIn, true>(lds, g, S, E, wave);
    }
    xcd_barrier(xbar);

    if constexpr (PH(3)) _Pragma("unroll") for (int rep_ = 0; rep_ < DUP(3); ++rep_) { FRESH_IDS();
      for (int rowb = gw * 16; rowb < MROWS; rowb += NGW * 16) {
        const int b = rowb >> 12, sb = rowb & 4095;
        const int ch0 = 8 * lane;
        f32x4 cw[4][2];
#pragma unroll
        for (int w = 0; w < 4; ++w) { cw[w][0] = *(const f32x4*)(conv_w + w * 512 + ch0); cw[w][1] = *(const f32x4*)(conv_w + w * 512 + ch0 + 4); }
        const f32x4 cb0 = *(const f32x4*)(conv_b + ch0), cb1 = *(const f32x4*)(conv_b + ch0 + 4);
        const float mul = (lane < 32) ? 1.f : 0.125f;
        const int chh = ch0 & 255, hh = chh >> 6, d = chh & 63;
        u32x4 win[3];
#pragma unroll
        for (int w = 0; w < 3; ++w) win[w] = (sb - 3 + w >= 0) ? *(const u32x4*)(Z + (size_t)(rowb - 3 + w) * DINP + ZQK + ch0) : (u32x4){0u, 0u, 0u, 0u};
#pragma unroll 2
        for (int k = 0; k < 16; ++k) {
            const int row = rowb + k, s = sb + k;
            const bf16_t* zr = Z + (size_t)row * DINP;
            const u32x4 cur = *(const u32x4*)(zr + ZQK + ch0);
            float sq = 0.f, skv = 0.f;
            if (lane < 48) { const u32x4 u = *(const u32x4*)(zr + ZQ + 8 * lane);
                const float e0 = bflo(u.x), e1 = bfhi(u.x), e2 = bflo(u.y), e3 = bfhi(u.y), e4 = bflo(u.z), e5 = bfhi(u.z), e6 = bflo(u.w), e7 = bfhi(u.w);
                sq = e0 * e0 + e1 * e1 + e2 * e2 + e3 * e3 + e4 * e4 + e5 * e5 + e6 * e6 + e7 * e7; }
            if (lane < 32) { const u32x4 u = *(const u32x4*)(zr + ZKV + 8 * lane);
                const float e0 = bflo(u.x), e1 = bfhi(u.x), e2 = bflo(u.y), e3 = bfhi(u.y), e4 = bflo(u.z), e5 = bfhi(u.z), e6 = bflo(u.w), e7 = bfhi(u.w);
                skv = e0 * e0 + e1 * e1 + e2 * e2 + e3 * e3 + e4 * e4 + e5 * e5 + e6 * e6 + e7 * e7; }
            sq = wave_sum(sq); skv = wave_sum(skv);
            if (lane == 0) { rstdq[row] = rsqrtf(sq * (1.f / QRANK) + EPS); rstdkv[row] = rsqrtf(skv * (1.f / KVRANK) + EPS); }
            if (lane < 16) {
                const float x1 = bf2f(zr[ZKR + lane]), x2 = bf2f(zr[ZKR + 16 + lane]);
                const float cs = cosT[row * 16 + lane], sn = sinT[row * 16 + lane];
                *(unsigned*)(Krope + (size_t)row * DROPE + 2 * lane) = cvtpk(x1 * cs - x2 * sn, x2 * cs + x1 * sn);
            }
            float acc[8] = {cb0[0], cb0[1], cb0[2], cb0[3], cb1[0], cb1[1], cb1[2], cb1[3]};
#pragma unroll
            for (int w = 0; w < 4; ++w) {
                const u32x4 u = (w < 3) ? win[w] : cur;
                acc[0] += bflo(u.x) * cw[w][0][0]; acc[1] += bfhi(u.x) * cw[w][0][1]; acc[2] += bflo(u.y) * cw[w][0][2]; acc[3] += bfhi(u.y) * cw[w][0][3];
                acc[4] += bflo(u.z) * cw[w][1][0]; acc[5] += bfhi(u.z) * cw[w][1][1]; acc[6] += bflo(u.w) * cw[w][1][2]; acc[7] += bfhi(u.w) * cw[w][1][3];
            }
            win[0] = win[1]; win[1] = win[2]; win[2] = cur;
#pragma unroll
            for (int j = 0; j < 8; ++j) acc[j] = siluf(acc[j]) * mul;
            u32x4 o; o.x = cvtpk(acc[0], acc[1]); o.y = cvtpk(acc[2], acc[3]); o.z = cvtpk(acc[4], acc[5]); o.w = cvtpk(acc[6], acc[7]);
            bf16_t* dst = ((lane < 32) ? Qm : Km) + ((size_t)((b * MH + hh) * SEQ + s)) * MDK + d;
            *(u32x4*)dst = o;
        }
      } }
    xcd_barrier(xbar);

    if constexpr (PH(12)) _Pragma("unroll") for (int rep_ = 0; rep_ < DUP(12); ++rep_) { FRESH_IDS(); for (int ch = gw; ch < NCH_TOT; ch += NGW) mlstm_chunk_state(ch, Z, Km, gates, dC, dn, mloc, btot, lane); }
    __syncthreads();
    if constexpr (PH(4)) _Pragma("unroll") for (int rep_ = 0; rep_ < DUP(4); ++rep_) {
        pg8::Gemm g{Z + ZQ, Bq, MROWS, 768, QRANK, DINP}; pg8::StaticOrder S; S.init(MROWS, 768, G, bx);
        EpiQ E{Qb};
        pg8::gemm_phase<EpiQ, true>(lds, g, S, E, wave);
    }
    if constexpr (PH(14)) _Pragma("unroll") for (int rep_ = 0; rep_ < DUP(14); ++rep_) {
        pg8::Gemm g{Z + ZKV, Bkv, MROWS, 1024, KVRANK, DINP}; pg8::StaticOrder S; S.init(MROWS, 1024, G, bx);
        EpiKV E{Kn, Vt, rstdkv};
        pg8::gemm_phase<EpiKV, true>(lds, g, S, E, wave);
    }
    xcd_barrier(xbar);

    {
        const int vcu = (G % 8 == 0) ? (bx % 8) * (G / 8) + bx / 8 : bx;
        if constexpr (PH(5)) _Pragma("unroll") for (int rep_ = 0; rep_ < DUP(5); ++rep_) { FRESH_IDS(); for (int v = vcu; v < 256; v += G) {
            const int bh = v >> 2, sidx = v & 3;
#pragma unroll 1
            for (int i = 0; i < 2; ++i) {
                const int qb = (i == 0) ? sidx : 7 - sidx;
                attn_unit(lds, Qb, Kn, Krope, Vt, HN, g_out_mla, rstdq, cosT, sinT, bh >> 3, bh & 7, qb, wave, lane);
            }
        } }
        if constexpr (PH(13)) _Pragma("unroll") for (int rep_ = 0; rep_ < DUP(13); ++rep_) { FRESH_IDS();
          for (int g0 = bx * 512; g0 < NB * MH * 4096; g0 += NT) {
            const int bh = g0 >> 12, p = (g0 & 4095) + tid;
            float m = 0.f, ca = 0.f, cb = 0.f, na = 0.f, nb = 0.f;
#pragma unroll 1
            for (int c0 = 0; c0 < NCHUNK; c0 += 16) {
                f32x2_t d[16], dd[16]; float ml[16], bt[16];
#pragma unroll
                for (int j = 0; j < 16; ++j) {
                    const int ch = bh * NCHUNK + c0 + j;
                    d[j] = *(const f32x2_t*)(dC + (size_t)ch * 8192 + 2 * p);
                    dd[j] = (p < 32) ? *(const f32x2_t*)(dn + (size_t)ch * 64 + 2 * p) : (f32x2_t){0.f, 0.f};
                    ml[j] = mloc[ch]; bt[j] = btot[ch];
                }
#pragma unroll
                for (int j = 0; j < 16; ++j) {
                    const int ch = bh * NCHUNK + c0 + j;
                    *(unsigned*)(C0 + (size_t)ch * 8192 + 2 * p) = cvtpk(ca, cb);
                    if (p < 32) { *(f32x2_t*)(n0buf + (size_t)ch * 64 + 2 * p) = (f32x2_t){na, nb}; if (p == 0) m0buf[ch] = m; }
                    const float mnew = fmaxf(bt[j] + m, ml[j]);
                    const float av = __expf(bt[j] + m - mnew), ev = __expf(ml[j] - mnew);
                    na = av * na + ev * dd[j][0]; nb = av * nb + ev * dd[j][1];
                    ca = av * ca + ev * d[j][0]; cb = av * cb + ev * d[j][1];
                    m = mnew;
                }
            }
          }
        }
    }
    xcd_barrier(xbar);

    if constexpr (PH(6)) _Pragma("unroll") for (int rep_ = 0; rep_ < DUP(6); ++rep_) { FRESH_IDS(); for (int ch = gw; ch < NCH_TOT; ch += NGW) mlstm_chunk_out(ch, Z, Qm, Km, gates, C0, n0buf, m0buf, g_out_mlstm, HN, lane); }
    xcd_barrier(xbar);

    if constexpr (PH(7)) _Pragma("unroll") for (int rep_ = 0; rep_ < DUP(7); ++rep_) {
        pg8::Gemm g{HN, Bout, MROWS, 1024, 1024, 1024}; pg8::StaticOrder S; S.init(MROWS, 1024, G, bx);
        EpiRes E{x, out, mod + 2048};
        pg8::gemm_phase<EpiRes, true>(lds, g, S, E, wave);
    }
    xcd_barrier(xbar);

    if constexpr (PH(8)) _Pragma("unroll") for (int rep_ = 0; rep_ < DUP(8); ++rep_) { FRESH_IDS(); for (int row = gw; row < MROWS; row += NGW) {
        const int b = row >> 12;
        const f32x4* xr = (const f32x4*)(out + (size_t)row * DM) + lane;
        f32x4 v[4]; float s = 0.f;
#pragma unroll
        for (int j = 0; j < 4; ++j) { v[j] = __builtin_nontemporal_load(xr + 64 * j); s += v[j][0] * v[j][0] + v[j][1] * v[j][1] + v[j][2] * v[j][2] + v[j][3] * v[j][3]; }
        const float rstd = rsqrtf(wave_sum(s) * (1.f / DM) + EPS);
        unsigned long long* o8 = (unsigned long long*)(HN + (size_t)row * DM) + lane;
#pragma unroll
        for (int j = 0; j < 4; ++j) {
            const int col = 4 * lane + 256 * j;
            const f32x4 g = *(const f32x4*)(g_ffn + col), sh = *(const f32x4*)(mod + b * 6144 + 3072 + col), sc = *(const f32x4*)(mod + b * 6144 + 4096 + col);
            const f32x4 h = (v[j] * rstd * g) * (sc + 1.f) + sh;
            o8[64 * j] = (unsigned long long)cvtpk(h[0], h[1]) | ((unsigned long long)cvtpk(h[2], h[3]) << 32);
        }
    } }
    xcd_barrier(xbar);

    if constexpr (PH(9)) _Pragma("unroll") for (int rep_ = 0; rep_ < DUP(9); ++rep_) {
        pg8::Gemm g{HN, Bgu, MROWS, 2 * DFF, 1024, 1024}; pg8::StaticOrder S; S.init(MROWS, 2 * DFF, G, bx);
        EpiGU E{ACT};
        pg8::gemm_phase<EpiGU, true>(lds, g, S, E, wave);
    }
    xcd_barrier(xbar);

    if constexpr (DUP(10) == 2) {
        pg8::Gemm g{ACT, Bd, MROWS, 1024, DFF, DFF}; pg8::StaticOrder S; S.init(MROWS, 1024, G, bx);
        EpiRes E{out, (float*)(ws + 288 * MiB), mod + 5120};
        pg8::gemm_phase<EpiRes, true>(lds, g, S, E, wave);
    }
    if (G == 256 && FUSE_FINAL_NORM) {
        pg8::Gemm g{ACT, Bd, MROWS, 1024, DFF, DFF}; pg8::StaticOrder S; S.init(MROWS, 1024, G, bx);
        EpiResNorm E{out, out, mod + 5120, g_final, (float*)(ws + WS_XBUF), (unsigned*)(ws + WS_PCNT), lds + 131072 + 2048};
        pg8::gemm_phase<EpiResNorm, true>(lds, g, S, E, wave);
    } else {
        {
            pg8::Gemm g{ACT, Bd, MROWS, 1024, DFF, DFF}; pg8::StaticOrder S; S.init(MROWS, 1024, G, bx);
            EpiRes E{out, out, mod + 5120};
            pg8::gemm_phase<EpiRes, true>(lds, g, S, E, wave);
        }
        xcd_barrier(xbar);
        { FRESH_IDS(); for (int row = gw; row < MROWS; row += NGW) {
            f32x4* xr = (f32x4*)(out + (size_t)row * DM) + lane;
            f32x4 v[4]; float s = 0.f;
#pragma unroll
            for (int j = 0; j < 4; ++j) { v[j] = xr[64 * j]; s += v[j][0] * v[j][0] + v[j][1] * v[j][1] + v[j][2] * v[j][2] + v[j][3] * v[j][3]; }
            const float rstd = rsqrtf(wave_sum(s) * (1.f / DM) + EPS);
#pragma unroll
            for (int j = 0; j < 4; ++j) { const f32x4 g = *(const f32x4*)(g_final + 4 * lane + 256 * j); xr[64 * j] = v[j] * rstd * g; }
        } }
    }
}

extern "C" void kernel_launch(void* const* d_in, const int* in_sizes, int n_in, void* d_out, int out_size, void* d_ws, size_t ws_size, hipStream_t stream) {
    static int grid_blocks = 0;
    if (grid_blocks == 0) {
        if (n_in != 22 || ws_size < WS_END) { fprintf(stderr, "kernel_launch: unexpected n_in %d / ws_size %zu (need %zu)\n", n_in, ws_size, (size_t)WS_END); grid_blocks = -1; return; }
        int dev = 0, cus = 0, per_cu = 0;
        hipGetDevice(&dev);
        hipDeviceGetAttribute(&cus, hipDeviceAttributeMultiprocessorCount, dev);
        if (hipFuncSetAttribute((const void*)fwd_megakernel, hipFuncAttributeMaxDynamicSharedMemorySize, LDS_BYTES) != hipSuccess) fprintf(stderr, "kernel_launch: hipFuncSetAttribute failed\n");
        if (hipOccupancyMaxActiveBlocksPerMultiprocessor(&per_cu, (const void*)fwd_megakernel, 512, LDS_BYTES) != hipSuccess || per_cu < 1) { fprintf(stderr, "kernel_launch: occupancy query gave %d\n", per_cu); per_cu = 1; }
        (void)hipGetLastError();
        grid_blocks = cus;
        if (grid_blocks > 256) grid_blocks = 256;
    }
    if (grid_blocks < 0) return;
    Args a{};
    for (int i = 0; i < 22; ++i) a.in[i] = d_in[i];
    a.out = (float*)d_out; a.ws = (unsigned char*)d_ws;
    if (hipMemsetAsync((unsigned char*)d_ws + WS_BARW, 0, XCD_BAR_WORDS * 4, stream) != hipSuccess) { fprintf(stderr, "kernel_launch: memset of the barrier words failed\n"); return; }
    void* args[] = {&a};
    hipError_t e = hipLaunchCooperativeKernel((const void*)fwd_megakernel, dim3(grid_blocks), dim3(512), args, LDS_BYTES, stream);
    if (e != hipSuccess) fprintf(stderr, "cooperative launch failed: %s (grid %d)\n", hipGetErrorString(e), grid_blocks);
}
```

```cpp
#include <hip/hip_runtime.h>
#include <hip/hip_cooperative_groups.h>
#include <cstdio>
#include <cstdint>
namespace cg = cooperative_groups;

#define LAS __attribute__((address_space(3)))
typedef unsigned short bf16_t;
typedef short bf16x8 __attribute__((ext_vector_type(8)));
typedef short s16x4 __attribute__((ext_vector_type(4)));
typedef float f32x4 __attribute__((ext_vector_type(4)));
typedef float f32x16 __attribute__((ext_vector_type(16)));
typedef unsigned u32x4 __attribute__((ext_vector_type(4)));
typedef unsigned u32x2 __attribute__((ext_vector_type(2)));
typedef float f32x2_t __attribute__((ext_vector_type(2)));
typedef __bf16 bf16x2_t __attribute__((ext_vector_type(2)));

constexpr int NB = 8, SEQ = 4096, DM = 1024, MROWS = NB * SEQ;
constexpr int NH = 8, DQK = 96, DNOPE = 64, DROPE = 32, DV = 64, QRANK = 384, KVRANK = 256;
constexpr int MH = 4, MDK = 64, MDV = 128, CHUNK = 64, NCHUNK = SEQ / CHUNK, NCH_TOT = NB * MH * NCHUNK;
constexpr int DIN = 2216, DINP = 2304, DFF = 2816, DMIX = 1024;
constexpr int ZQ = 0, ZKV = 384, ZKR = 640, ZQK = 672, ZV = 1184, ZO = 1696, ZI = 2208;
constexpr float EPS = 1e-6f;
constexpr float QSCALE = 0.10206207261596575f * 1.4426950408889634f;

constexpr size_t MiB = 1u << 20;
constexpr size_t WS_MOD = 0, WS_COS = 1 * MiB, WS_SIN = 3 * MiB, WS_RSTDQ = 5 * MiB, WS_RSTDKV = 5 * MiB + 256 * 1024;
constexpr size_t WS_GATES = 6 * MiB, WS_MLOC = 7 * MiB, WS_BTOT = 7 * MiB + 64 * 1024, WS_M0 = 7 * MiB + 128 * 1024;
constexpr size_t WS_BARW = 9 * MiB + 512 * 1024;
constexpr size_t WS_PCNT = 9 * MiB + 768 * 1024;
constexpr size_t WS_XBUF2 = 10 * MiB + 512 * 1024; constexpr size_t WS_XG = 304 * MiB;
constexpr size_t WS_XBUF = 10 * MiB;
constexpr size_t WS_DN = 8 * MiB, WS_N0 = 8 * MiB + 512 * 1024;
constexpr size_t WS_BIN = 16 * MiB, WS_BQ = 21 * MiB, WS_BKV = 22 * MiB, WS_BOUT = 23 * MiB, WS_BGU = 25 * MiB, WS_BD = 36 * MiB;
constexpr size_t WS_KROPE = 42 * MiB;
constexpr size_t WS_HN = 48 * MiB;
constexpr size_t WS_Z = 112 * MiB;
constexpr size_t WS_Q = 256 * MiB, WS_KN = 304 * MiB, WS_VT = 336 * MiB, WS_QM = 368 * MiB, WS_KM = 384 * MiB;
constexpr size_t WS_DC = 400 * MiB, WS_C0 = 464 * MiB, WS_END = 496 * MiB;
constexpr size_t WS_ACT = 112 * MiB;

__device__ __forceinline__ unsigned cvtpk(float lo, float hi) { f32x2_t v = {lo, hi}; bf16x2_t b = __builtin_convertvector(v, bf16x2_t); return __builtin_bit_cast(unsigned, b); }
__device__ __forceinline__ float bf2f(unsigned short u) { return __uint_as_float(((unsigned)u) << 16); }
__device__ __forceinline__ float bflo(unsigned u) { return __uint_as_float(u << 16); }
__device__ __forceinline__ float bfhi(unsigned u) { return __uint_as_float(u & 0xffff0000u); }
__device__ __forceinline__ unsigned short f2bf(float f) { return (unsigned short)(cvtpk(f, 0.f) & 0xffffu); }
template <int CTRL> __device__ __forceinline__ float dpp_f(float v) { return __uint_as_float((unsigned)__builtin_amdgcn_update_dpp(0, (int)__float_as_uint(v), CTRL, 0xF, 0xF, true)); }
__device__ __forceinline__ float wave_sum(float v) {
    v += dpp_f<0xB1>(v);
    v += dpp_f<0x4E>(v);
    v += dpp_f<0x141>(v);
    v += dpp_f<0x140>(v);
    { const auto r = __builtin_amdgcn_permlane16_swap(__float_as_uint(v), __float_as_uint(v), false, false); v = __uint_as_float(r[0]) + __uint_as_float(r[1]); }
    { const auto r = __builtin_amdgcn_permlane32_swap(__float_as_uint(v), __float_as_uint(v), false, false); v = __uint_as_float(r[0]) + __uint_as_float(r[1]); }
    return v;
}
__device__ __forceinline__ float wave_max(float v) {
#pragma unroll
    for (int o = 1; o < 64; o <<= 1) v = fmaxf(v, __shfl_xor(v, o));
    return v;
}
__device__ __forceinline__ int fresh_lane() { int l; asm volatile("v_mbcnt_lo_u32_b32 %0, -1, 0\n\tv_mbcnt_hi_u32_b32 %0, -1, %0" : "=v"(l)); return l & 63; }
__device__ __forceinline__ int crow(int r, int hi) { return (r & 3) + 8 * (r >> 2) + 4 * hi; }
__device__ __forceinline__ float siluf(float x) { return x * __builtin_amdgcn_rcpf(1.f + __expf(-x)); }
__device__ __forceinline__ float sigmoidf_(float x) { return __builtin_amdgcn_rcpf(1.f + __expf(-x)); }
__device__ __forceinline__ float logsigmoidf_(float x) { return fminf(x, 0.f) - log1pf(expf(-fabsf(x))); }

namespace pg8 {
constexpr int BM = 256, BK = 64, HALF = 128, HTB = HALF * BK * 2, STAGE_BYTES = 8 * HTB, NXCD = 8, WGM = 8;
__host__ __device__ __forceinline__ int lds_byte(int r, int c) { const int st = (r >> 4) * 2 + (c >> 5), rr = r & 15, cc = c & 31, ob = rr * 64 + cc * 2; return st * 1024 + (ob ^ (((ob >> 9) & 1) << 5)); }
__host__ __device__ __forceinline__ void stage_rc(int b, int& R, int& C) { const int st = b / 1024, sb = b % 1024, swz = sb ^ (((sb >> 9) & 1) << 5); R = (st >> 1) * 16 + swz / 64; C = (st & 1) * 32 + (swz % 64) / 2; }
__host__ __device__ __forceinline__ int perm32(int rho) { const int n = rho >> 4, i = rho & 15; return 8 * (i >> 2) + 4 * n + (i & 3); }
struct Unit { int pm, pn; };
struct Gemm { const bf16_t* A; const bf16_t* Bt; int M, N, K, lda; };
struct StaticOrder {
    int nM, nN, nwg, G, c;
    __device__ void init(int M, int N, int G_, int c_) { nM = M / BM; nN = N / BM; nwg = nM * nN; G = G_; c = c_; }
    __device__ bool next(int i, Unit& u) const {
        const long L = (long)i * G + c; if (L >= nwg) return false;
        int wgid = (int)L; { const int q = nwg / NXCD, r = nwg % NXCD, xcd = wgid % NXCD, off = wgid / NXCD; wgid = (xcd < r ? xcd * (q + 1) : r * (q + 1) + (xcd - r) * q) + off; }
        const int nig = WGM * nN, gid = wgid / nig, fm = gid * WGM, gsz = (nM - fm) < WGM ? (nM - fm) : WGM;
        u.pm = fm + ((wgid % nig) % gsz); u.pn = (wgid % nig) / gsz; return true;
    }
};
struct NoHook { __device__ __forceinline__ void operator()(const Unit&, int) const {} };
template <class Epi, bool ALIGN_EPI, class Hook = NoHook>
__device__ __forceinline__ void gemm_phase(LAS unsigned char* lds, const Gemm g, const StaticOrder& S, const Epi& E, const int wave_id, const Hook& H = Hook()) {
    const int lane = fresh_lane();
    const int wid = wave_id, tid = wid * 64 + lane, wr = wid >> 2, wc = wid & 3, fr = lane & 15, fq = lane >> 4;
    const int K = g.K, nt = K / BK, lda = g.lda;
    unsigned voffA[2], voffB[2];
#pragma unroll
    for (int i = 0; i < 2; ++i) { int R, C; stage_rc(tid * 16 + i * 8192, R, C); const int Rb = (R & ~31) + perm32(R & 31);
        voffA[i] = (unsigned)(R * lda + C) * 2u; voffB[i] = (unsigned)(Rb * K + C) * 2u; }
    const size_t kstep = (size_t)(BK * 2);
    const size_t hstepA = (size_t)HALF * lda * 2, hstepB = (size_t)HALF * K * 2;
    const size_t tstepA = 2 * hstepA, tstepB = 2 * hstepB;
    const unsigned ldsw = (unsigned)wid * 1024u;
    const int aoff = lds_byte(wr * 64 + fr, fq * 8), boff = lds_byte(wc * 32 + fr, fq * 8);
#define PG8_SA(b, h) (((b) * 2 + (h)) * HTB)
#define PG8_SB(b, h) ((4 + (b) * 2 + (h)) * HTB)
#define PG8_STAGE(bufoff, gbase, voff) do { _Pragma("unroll") for (int _i = 0; _i < 2; ++_i) \
        __builtin_amdgcn_global_load_lds((const unsigned*)((const char*)(gbase) + (voff)[_i]), (LAS unsigned*)(lds + (bufoff) + ldsw + _i * 8192), 16, 0, 0); } while (0)
#define PG8_LDA(dst, b, h) do { _Pragma("unroll") for (int m = 0; m < 4; ++m) _Pragma("unroll") for (int k = 0; k < 2; ++k) dst[m][k] = *(const LAS bf16x8*)(lds + PG8_SA(b, h) + aoff + m * 2048 + k * 1024); } while (0)
#define PG8_LDB(dst, b, h) do { _Pragma("unroll") for (int n = 0; n < 2; ++n) _Pragma("unroll") for (int k = 0; k < 2; ++k) dst[n][k] = *(const LAS bf16x8*)(lds + PG8_SB(b, h) + boff + n * 2048 + k * 1024); } while (0)
#define PG8_MMA(ai, bj, At, Bt) do { __builtin_amdgcn_s_setprio(1); _Pragma("unroll") for (int m = 0; m < 4; ++m) _Pragma("unroll") for (int n = 0; n < 2; ++n) _Pragma("unroll") for (int k = 0; k < 2; ++k) \
        acc[ai][bj][m][n] = __builtin_amdgcn_mfma_f32_16x16x32_bf16(Bt[n][k], At[m][k], acc[ai][bj][m][n], 0, 0, 0); __builtin_amdgcn_s_setprio(0); } while (0)
#define PG8_WAIT_V(n) asm volatile("s_waitcnt vmcnt(" #n ")" ::: "memory")
#define PG8_WAIT_L(n) asm volatile("s_waitcnt lgkmcnt(" #n ")" ::: "memory")
#define PG8_BAR __builtin_amdgcn_s_barrier()
#define PG8_SCHED __builtin_amdgcn_sched_barrier(0)
    Unit cur, nxt; int ui = 0;
    if (!S.next(0, cur)) return;
    f32x4 acc[2][2][4][2];
#pragma unroll
    for (int a = 0; a < 2; ++a)
#pragma unroll
        for (int b = 0; b < 2; ++b)
#pragma unroll
            for (int m = 0; m < 4; ++m)
#pragma unroll
                for (int n = 0; n < 2; ++n) acc[a][b][m][n] = (f32x4){0.f, 0.f, 0.f, 0.f};
    bf16x8 At[4][2], B0[2][2], B1[2][2];
    const char* cA = (const char*)g.A + (size_t)cur.pm * tstepA; const char* cB = (const char*)g.Bt + (size_t)cur.pn * tstepB;
    PG8_STAGE(PG8_SB(0, 0), cB, voffB); PG8_STAGE(PG8_SB(0, 1), cB + hstepB, voffB); PG8_STAGE(PG8_SA(0, 0), cA, voffA); PG8_STAGE(PG8_SA(0, 1), cA + hstepA, voffA);
    if (wr == 1) PG8_BAR;
    PG8_WAIT_V(2); PG8_BAR;
    PG8_STAGE(PG8_SB(1, 0), cB + kstep, voffB); PG8_STAGE(PG8_SA(1, 0), cA + kstep, voffA); PG8_STAGE(PG8_SB(1, 1), cB + hstepB + kstep, voffB);
    PG8_WAIT_V(6); PG8_BAR;
    for (;;) {
        const bool has_next = S.next(ui + 1, nxt);
        const char* nA = has_next ? (const char*)g.A + (size_t)nxt.pm * tstepA : cA; const char* nB = has_next ? (const char*)g.Bt + (size_t)nxt.pn * tstepB : cB;
        for (int t = 0; t < nt; t += 2) {
            const bool last = (t == nt - 2);
            const char* a1 = cA + (size_t)(t + 1) * kstep;
            const char* a2 = last ? nA : cA + (size_t)(t + 2) * kstep; const char* b2 = last ? nB : cB + (size_t)(t + 2) * kstep;
            const char* a3 = a2 + kstep; const char* b3 = b2 + kstep;
            PG8_LDB(B0, 0, 0); PG8_LDB(B1, 0, 1); PG8_SCHED; PG8_LDA(At, 0, 0); PG8_STAGE(PG8_SA(1, 1), a1 + hstepA, voffA);
            PG8_WAIT_V(8); PG8_WAIT_L(0); PG8_BAR; PG8_MMA(0, 0, At, B0); PG8_MMA(0, 1, At, B1); PG8_BAR; PG8_SCHED;
            PG8_LDA(At, 0, 1); PG8_STAGE(PG8_SB(0, 0), b2, voffB); PG8_STAGE(PG8_SB(0, 1), b2 + hstepB, voffB); PG8_STAGE(PG8_SA(0, 0), a2, voffA);
            PG8_WAIT_V(8); PG8_WAIT_L(0); PG8_BAR; PG8_MMA(1, 0, At, B0); PG8_MMA(1, 1, At, B1); PG8_BAR; PG8_SCHED;
            PG8_LDB(B0, 1, 0); PG8_LDB(B1, 1, 1); PG8_SCHED; PG8_LDA(At, 1, 0); PG8_STAGE(PG8_SA(0, 1), a2 + hstepA, voffA);
            PG8_WAIT_V(8); PG8_WAIT_L(0); PG8_BAR; PG8_MMA(0, 0, At, B0); PG8_MMA(0, 1, At, B1); PG8_BAR; PG8_SCHED;
            PG8_LDA(At, 1, 1); PG8_STAGE(PG8_SB(1, 0), b3, voffB); PG8_STAGE(PG8_SB(1, 1), b3 + hstepB, voffB); PG8_STAGE(PG8_SA(1, 0), a3, voffA);
            PG8_WAIT_V(8); PG8_WAIT_L(0); PG8_BAR; PG8_MMA(1, 0, At, B0); PG8_MMA(1, 1, At, B1); PG8_BAR; PG8_SCHED;
        }
        if constexpr (ALIGN_EPI) { if (wr == 0) PG8_BAR; }
        E(acc, cur, wr, wc, fr, fq);
        H(cur, wid);
        if (!has_next) break;
#pragma unroll
        for (int a = 0; a < 2; ++a)
#pragma unroll
            for (int b = 0; b < 2; ++b)
#pragma unroll
                for (int m = 0; m < 4; ++m)
#pragma unroll
                    for (int n = 0; n < 2; ++n) acc[a][b][m][n] = (f32x4){0.f, 0.f, 0.f, 0.f};
        cur = nxt; cA = nA; cB = nB; ++ui;
        if constexpr (ALIGN_EPI) { if (wr == 1) PG8_BAR; }
    }
    PG8_WAIT_V(0);
    if constexpr (!ALIGN_EPI) { if (wr == 0) PG8_BAR; }
    PG8_BAR;
#undef PG8_SA
#undef PG8_SB
#undef PG8_STAGE
#undef PG8_LDA
#undef PG8_LDB
#undef PG8_MMA
#undef PG8_WAIT_V
#undef PG8_WAIT_L
#undef PG8_BAR
#undef PG8_SCHED
}
}

typedef f32x4 AccT[2][2][4][2];
#define EPI_LOOP_BEGIN \
    _Pragma("unroll") for (int ai = 0; ai < 2; ++ai) _Pragma("unroll") for (int m = 0; m < 4; ++m) { const int row = u.pm * 256 + ai * 128 + wr * 64 + m * 16 + fr; \
    _Pragma("unroll") for (int bj = 0; bj < 2; ++bj) { const int col = u.pn * 256 + bj * 128 + wc * 32 + 8 * fq; const f32x4 v0 = acc[ai][bj][m][0], v1 = acc[ai][bj][m][1];
#define EPI_LOOP_END } asm volatile("" ::: "memory"); }

struct EpiIn {
    bf16_t* Z; float* gates; const float* bg;
    __device__ __forceinline__ void operator()(const AccT& acc, const pg8::Unit& u, int wr, int wc, int fr, int fq) const {
        { const int l_ = fresh_lane(); fr = l_ & 15; fq = l_ >> 4; }
        EPI_LOOP_BEGIN
            u32x4 w; w.x = cvtpk(v0[0], v0[1]); w.y = cvtpk(v0[2], v0[3]); w.z = cvtpk(v1[0], v1[1]); w.w = cvtpk(v1[2], v1[3]);
            *(u32x4*)(Z + (size_t)row * DINP + col) = w;
            if (col == ZI) {
                const f32x4 b0 = *(const f32x4*)(bg), b1 = *(const f32x4*)(bg + 4);
                *(f32x4*)(gates + (size_t)row * 8) = v0 + b0; *(f32x4*)(gates + (size_t)row * 8 + 4) = v1 + b1;
            }
        EPI_LOOP_END
    }
};
struct EpiQ {
    bf16_t* Q;
    __device__ __forceinline__ void operator()(const AccT& acc, const pg8::Unit& u, int wr, int wc, int fr, int fq) const {
        { const int l_ = fresh_lane(); fr = l_ & 15; fq = l_ >> 4; }
        const int row0 = u.pm * 256 + wr * 64 + fr; const int b = row0 >> 12, s0 = row0 & 4095;
#pragma unroll
        for (int bj = 0; bj < 2; ++bj) {
            const int col = u.pn * 256 + bj * 128 + wc * 32 + 8 * fq; const int head = col / 96, w = col - head * 96;
            bf16_t* pb = Q + ((size_t)((b * NH + head) * SEQ + s0)) * DQK + w;
#pragma unroll
            for (int ai = 0; ai < 2; ++ai)
#pragma unroll
                for (int m = 0; m < 4; ++m) {
                    const f32x4 v0 = acc[ai][bj][m][0], v1 = acc[ai][bj][m][1];
                    u32x4 o; o.x = cvtpk(v0[0], v0[1]); o.y = cvtpk(v0[2], v0[3]); o.z = cvtpk(v1[0], v1[1]); o.w = cvtpk(v1[2], v1[3]);
                    *(u32x4*)(pb + (ai * 128 + m * 16) * DQK) = o;
                }
            asm volatile("" ::: "memory");
        }
    }
};
struct EpiKV {
    bf16_t* Kn; bf16_t* Vt; const float* rstd;
    __device__ __forceinline__ void operator()(const AccT& acc, const pg8::Unit& u, int wr, int wc, int fr, int fq) const {
        { const int l_ = fresh_lane(); fr = l_ & 15; fq = l_ >> 4; }
        const int row0 = u.pm * 256 + wr * 64 + fr; const int b = row0 >> 12, s0 = row0 & 4095;
        const int w = wc * 32 + 8 * fq;
        const int posfr = (((fr >> 2) & 1) << 3) | (((fr >> 3) & 1) << 2) | (fr & 3);
#pragma unroll
        for (int bj = 0; bj < 2; ++bj) {
            const int head = u.pn * 2 + bj;
            bf16_t* pk = Kn + ((size_t)((b * NH + head) * SEQ + s0)) * DNOPE + w;
            bf16_t* pv = Vt + ((size_t)((b * NH + head) * (SEQ / 32) + (s0 >> 5))) * (DV * 32) + (w - 64) * 32 + posfr;
#pragma unroll
            for (int ai = 0; ai < 2; ++ai)
#pragma unroll
                for (int m = 0; m < 4; ++m) {
                    const float sc = rstd[row0 + ai * 128 + m * 16];
                    const f32x4 a0 = acc[ai][bj][m][0] * sc, a1 = acc[ai][bj][m][1] * sc;
                    if (wc < 2) {
                        u32x4 o; o.x = cvtpk(a0[0], a0[1]); o.y = cvtpk(a0[2], a0[3]); o.z = cvtpk(a1[0], a1[1]); o.w = cvtpk(a1[2], a1[3]);
                        *(u32x4*)(pk + (ai * 128 + m * 16) * DNOPE) = o;
                    } else {
                        bf16_t* p = pv + (ai * 4 + (m >> 1)) * (DV * 32) + 16 * (m & 1);
                        p[0 * 32] = f2bf(a0[0]); p[1 * 32] = f2bf(a0[1]); p[2 * 32] = f2bf(a0[2]); p[3 * 32] = f2bf(a0[3]);
                        p[4 * 32] = f2bf(a1[0]); p[5 * 32] = f2bf(a1[1]); p[6 * 32] = f2bf(a1[2]); p[7 * 32] = f2bf(a1[3]);
                    }
                    asm volatile("" ::: "memory");
                }
        }
    }
};
struct EpiRes {
    const float* base; float* out; const float* gate;
    __device__ __forceinline__ void operator()(const AccT& acc, const pg8::Unit& u, int wr, int wc, int fr, int fq) const {
        { const int l_ = fresh_lane(); fr = l_ & 15; fq = l_ >> 4; }
        const int row0 = u.pm * 256 + wr * 64 + fr; const int b = row0 >> 12;
        const int col0 = u.pn * 256 + wc * 32 + 8 * fq;
        f32x4 g[2][2];
#pragma unroll
        for (int bj = 0; bj < 2; ++bj) { g[bj][0] = *(const f32x4*)(gate + b * 6144 + col0 + bj * 128); g[bj][1] = *(const f32x4*)(gate + b * 6144 + col0 + bj * 128 + 4); }
#pragma unroll
        for (int ai = 0; ai < 2; ++ai) {
            f32x4 xv[4][2][2];
#pragma unroll
            for (int m = 0; m < 4; ++m)
#pragma unroll
                for (int bj = 0; bj < 2; ++bj) { const size_t off = (size_t)(row0 + ai * 128 + m * 16) * DM + col0 + bj * 128; xv[m][bj][0] = __builtin_nontemporal_load((const f32x4*)(base + off)); xv[m][bj][1] = __builtin_nontemporal_load((const f32x4*)(base + off + 4)); }
#pragma unroll
            for (int m = 0; m < 4; ++m)
#pragma unroll
                for (int bj = 0; bj < 2; ++bj) { const size_t off = (size_t)(row0 + ai * 128 + m * 16) * DM + col0 + bj * 128;
                    *(f32x4*)(out + off) = xv[m][bj][0] + g[bj][0] * acc[ai][bj][m][0]; *(f32x4*)(out + off + 4) = xv[m][bj][1] + g[bj][1] * acc[ai][bj][m][1]; }
            asm volatile("" ::: "memory");
        }
    }
};
struct EpiResNorm {
    const float* base; float* out; const float* gate; const float* gfin;
    float* xbuf;
    unsigned* cnt;
    LAS unsigned char* l;
    __device__ __forceinline__ void operator()(AccT& acc, const pg8::Unit& u, int wr, int wc, int fr, int fq) const {
        const int lane = fresh_lane(); fr = lane & 15; fq = lane >> 4;
        const int wid = wr * 4 + wc;
        const int row0 = u.pm * 256 + wr * 64 + fr; const int b = row0 >> 12;
        const int col0 = u.pn * 256 + wc * 32 + 8 * fq;
        LAS float* P = (LAS float*)l; LAS float* S = (LAS float*)(l + 4096); volatile LAS unsigned* flag = (volatile LAS unsigned*)(l + 4096 + 1024);
        float sp[2][4];
        {
            f32x4 g[2][2];
#pragma unroll
            for (int bj = 0; bj < 2; ++bj) { g[bj][0] = *(const f32x4*)(gate + b * 6144 + col0 + bj * 128); g[bj][1] = *(const f32x4*)(gate + b * 6144 + col0 + bj * 128 + 4); }
#pragma unroll
            for (int am = 0; am < 4; ++am) {
                const int ai = am >> 1, mb = (am & 1) * 2;
                f32x4 xv[2][2][2];
#pragma unroll
                for (int m2 = 0; m2 < 2; ++m2)
#pragma unroll
                    for (int bj = 0; bj < 2; ++bj) { const size_t off = (size_t)(row0 + ai * 128 + (mb + m2) * 16) * DM + col0 + bj * 128; xv[m2][bj][0] = *(const f32x4*)(base + off); xv[m2][bj][1] = *(const f32x4*)(base + off + 4); }
#pragma unroll
                for (int m2 = 0; m2 < 2; ++m2) {
                    const int m = mb + m2;
                    float q = 0.f;
#pragma unroll
                    for (int bj = 0; bj < 2; ++bj) {
                        const f32x4 r0 = xv[m2][bj][0] + g[bj][0] * acc[ai][bj][m][0], r1 = xv[m2][bj][1] + g[bj][1] * acc[ai][bj][m][1];
                        acc[ai][bj][m][0] = r0; acc[ai][bj][m][1] = r1;
                        q += (r0[0] * r0[0] + r0[1] * r0[1]) + (r0[2] * r0[2] + r0[3] * r0[3]) + (r1[0] * r1[0] + r1[1] * r1[1]) + (r1[2] * r1[2] + r1[3] * r1[3]);
                    }
                    q += __shfl_xor(q, 16); q += __shfl_xor(q, 32);
                    sp[ai][m] = q;
                }
                asm volatile("" ::: "memory");
            }
        }
        if (fq == 0) {
#pragma unroll
            for (int ai = 0; ai < 2; ++ai)
#pragma unroll
                for (int m = 0; m < 4; ++m) P[(ai * 128 + wr * 64 + m * 16 + fr) * 4 + wc] = sp[ai][m];
        }
        asm volatile("s_waitcnt lgkmcnt(0)" ::: "memory"); __builtin_amdgcn_s_barrier(); asm volatile("" ::: "memory");
        const int prow = wid * 32 + (lane & 31);
        if (lane < 32) {
            const float t = (P[prow * 4 + 0] + P[prow * 4 + 1]) + (P[prow * 4 + 2] + P[prow * 4 + 3]);
            __hip_atomic_store((unsigned*)xbuf + (size_t)(u.pm * 256 + prow) * 4 + u.pn, __float_as_uint(t), __ATOMIC_RELAXED, __HIP_MEMORY_SCOPE_AGENT);
        }
        asm volatile("s_waitcnt vmcnt(0)" ::: "memory");
        if (lane == 0) __hip_atomic_fetch_add(cnt + u.pm, 1u, __ATOMIC_RELAXED, __HIP_MEMORY_SCOPE_AGENT);
        if (wid == 0) {
            unsigned spins = 0;
            while ((unsigned)__builtin_amdgcn_readfirstlane(__hip_atomic_load(cnt + u.pm, __ATOMIC_RELAXED, __HIP_MEMORY_SCOPE_AGENT)) < 32u) { __builtin_amdgcn_s_sleep(2); if (++spins > (1u << 22)) break; }
            __builtin_amdgcn_fence(__ATOMIC_ACQUIRE, "agent");
            if (lane == 0) flag[0] = 1u;
        }
        asm volatile("s_waitcnt vmcnt(0) lgkmcnt(0)" ::: "memory"); __builtin_amdgcn_s_barrier(); asm volatile("" ::: "memory");
        if (lane < 32) {
            const unsigned* slot = (const unsigned*)xbuf + (size_t)(u.pm * 256 + prow) * 4;
            float t = 0.f;
#pragma unroll
            for (int k = 0; k < 4; ++k) t += __uint_as_float(__hip_atomic_load(slot + k, __ATOMIC_RELAXED, __HIP_MEMORY_SCOPE_AGENT));
            S[prow] = rsqrtf(t * (1.f / DM) + EPS);
        }
        asm volatile("s_waitcnt lgkmcnt(0)" ::: "memory"); __builtin_amdgcn_s_barrier(); asm volatile("" ::: "memory");
        f32x4 gf[2][2];
#pragma unroll
        for (int bj = 0; bj < 2; ++bj) { gf[bj][0] = *(const f32x4*)(gfin + col0 + bj * 128); gf[bj][1] = *(const f32x4*)(gfin + col0 + bj * 128 + 4); }
#pragma unroll
        for (int ai = 0; ai < 2; ++ai)
#pragma unroll
            for (int m = 0; m < 4; ++m) {
                const float rs = S[ai * 128 + wr * 64 + m * 16 + fr];
#pragma unroll
                for (int bj = 0; bj < 2; ++bj) { const size_t off = (size_t)(row0 + ai * 128 + m * 16) * DM + col0 + bj * 128;
                    *(f32x4*)(out + off) = acc[ai][bj][m][0] * rs * gf[bj][0]; *(f32x4*)(out + off + 4) = acc[ai][bj][m][1] * rs * gf[bj][1]; }
            }
        asm volatile("s_waitcnt lgkmcnt(0)" ::: "memory");
    }
};
struct EpiOutNorm {
    const float* base; float* out; const float* gate; const float* gfin; const float* modf; bf16_t* XG;
    float* xbuf;
    unsigned* cnt;
    LAS unsigned char* l;
    __device__ __forceinline__ void operator()(AccT& acc, const pg8::Unit& u, int wr, int wc, int fr, int fq) const {
        const int lane = fresh_lane(); fr = lane & 15; fq = lane >> 4;
        const int wid = wr * 4 + wc;
        const int row0 = u.pm * 256 + wr * 64 + fr; const int b = row0 >> 12;
        const int col0 = u.pn * 256 + wc * 32 + 8 * fq;
        LAS float* P = (LAS float*)l; LAS float* S = (LAS float*)(l + 4096); volatile LAS unsigned* flag = (volatile LAS unsigned*)(l + 4096 + 1024);
        float sp[2][4];
        {
            f32x4 g[2][2];
#pragma unroll
            for (int bj = 0; bj < 2; ++bj) { g[bj][0] = *(const f32x4*)(gate + b * 6144 + col0 + bj * 128); g[bj][1] = *(const f32x4*)(gate + b * 6144 + col0 + bj * 128 + 4); }
#pragma unroll
            for (int am = 0; am < 4; ++am) {
                const int ai = am >> 1, mb = (am & 1) * 2;
                f32x4 xv[2][2][2];
#pragma unroll
                for (int m2 = 0; m2 < 2; ++m2)
#pragma unroll
                    for (int bj = 0; bj < 2; ++bj) { const size_t off = (size_t)(row0 + ai * 128 + (mb + m2) * 16) * DM + col0 + bj * 128; xv[m2][bj][0] = __builtin_nontemporal_load((const f32x4*)(base + off)); xv[m2][bj][1] = __builtin_nontemporal_load((const f32x4*)(base + off + 4)); }
#pragma unroll
                for (int m2 = 0; m2 < 2; ++m2) {
                    const int m = mb + m2;
                    float q = 0.f;
#pragma unroll
                    for (int bj = 0; bj < 2; ++bj) {
                        const f32x4 r0 = xv[m2][bj][0] + g[bj][0] * acc[ai][bj][m][0], r1 = xv[m2][bj][1] + g[bj][1] * acc[ai][bj][m][1];
                        acc[ai][bj][m][0] = r0; acc[ai][bj][m][1] = r1;
                        { const size_t offx = (size_t)(row0 + ai * 128 + m * 16) * DM + col0 + bj * 128; *(f32x4*)(out + offx) = r0; *(f32x4*)(out + offx + 4) = r1; }
                        q += (r0[0] * r0[0] + r0[1] * r0[1]) + (r0[2] * r0[2] + r0[3] * r0[3]) + (r1[0] * r1[0] + r1[1] * r1[1]) + (r1[2] * r1[2] + r1[3] * r1[3]);
                    }
                    q += __shfl_xor(q, 16); q += __shfl_xor(q, 32);
                    sp[ai][m] = q;
                }
                asm volatile("" ::: "memory");
            }
        }
        if (fq == 0) {
#pragma unroll
            for (int ai = 0; ai < 2; ++ai)
#pragma unroll
                for (int m = 0; m < 4; ++m) P[(ai * 128 + wr * 64 + m * 16 + fr) * 4 + wc] = sp[ai][m];
        }
        asm volatile("s_waitcnt lgkmcnt(0)" ::: "memory"); __builtin_amdgcn_s_barrier(); asm volatile("" ::: "memory");
        const int prow = wid * 32 + (lane & 31);
        if (lane < 32) {
            const float t = (P[prow * 4 + 0] + P[prow * 4 + 1]) + (P[prow * 4 + 2] + P[prow * 4 + 3]);
            __hip_atomic_store((unsigned*)xbuf + (size_t)(u.pm * 256 + prow) * 4 + u.pn, __float_as_uint(t), __ATOMIC_RELAXED, __HIP_MEMORY_SCOPE_AGENT);
        }
        asm volatile("s_waitcnt vmcnt(0)" ::: "memory");
        if (lane == 0) __hip_atomic_fetch_add(cnt + u.pm, 1u, __ATOMIC_RELAXED, __HIP_MEMORY_SCOPE_AGENT);
        if (wid == 0) {
            unsigned spins = 0;
            while ((unsigned)__builtin_amdgcn_readfirstlane(__hip_atomic_load(cnt + u.pm, __ATOMIC_RELAXED, __HIP_MEMORY_SCOPE_AGENT)) < 32u) { __builtin_amdgcn_s_sleep(2); if (++spins > (1u << 22)) break; }
            __builtin_amdgcn_fence(__ATOMIC_ACQUIRE, "agent");
            if (lane == 0) flag[0] = 1u;
        }
        asm volatile("s_waitcnt vmcnt(0) lgkmcnt(0)" ::: "memory"); __builtin_amdgcn_s_barrier(); asm volatile("" ::: "memory");
        if (lane < 32) {
            const unsigned* slot = (const unsigned*)xbuf + (size_t)(u.pm * 256 + prow) * 4;
            float t = 0.f;
#pragma unroll
            for (int k = 0; k < 4; ++k) t += __uint_as_float(__hip_atomic_load(slot + k, __ATOMIC_RELAXED, __HIP_MEMORY_SCOPE_AGENT));
            S[prow] = rsqrtf(t * (1.f / DM) + EPS);
        }
        asm volatile("s_waitcnt lgkmcnt(0)" ::: "memory"); __builtin_amdgcn_s_barrier(); asm volatile("" ::: "memory");
#pragma unroll
        for (int bj = 0; bj < 2; ++bj) {
            const int col = col0 + bj * 128;
            const f32x4 f0 = *(const f32x4*)(gfin + col) * (*(const f32x4*)(modf + b * 6144 + 4096 + col) + 1.f), f1 = *(const f32x4*)(gfin + col + 4) * (*(const f32x4*)(modf + b * 6144 + 4096 + col + 4) + 1.f);
            const f32x4 h0 = *(const f32x4*)(modf + b * 6144 + 3072 + col), h1 = *(const f32x4*)(modf + b * 6144 + 3072 + col + 4);
#pragma unroll
            for (int ai = 0; ai < 2; ++ai)
#pragma unroll
                for (int m = 0; m < 4; ++m) {
                    const float rs = S[ai * 128 + wr * 64 + m * 16 + fr];
                    const f32x4 v0 = acc[ai][bj][m][0] * rs * f0 + h0, v1 = acc[ai][bj][m][1] * rs * f1 + h1;
                    u32x4 w; w.x = cvtpk(v0[0], v0[1]); w.y = cvtpk(v0[2], v0[3]); w.z = cvtpk(v1[0], v1[1]); w.w = cvtpk(v1[2], v1[3]);
                    *(u32x4*)(XG + (size_t)(row0 + ai * 128 + m * 16) * DM + col) = w;
                }
        }
        asm volatile("s_waitcnt lgkmcnt(0)" ::: "memory");
    }
};
struct EpiGU {
    static constexpr bool PREFETCH = false;
    bf16_t* act;
    __device__ __forceinline__ void operator()(const AccT& acc, const pg8::Unit& u, int wr, int wc, int fr, int fq) const {
        { const int l_ = fresh_lane(); fr = l_ & 15; fq = l_ >> 4; }
        const int odd = fq & 1;
        const int row0 = u.pm * 256 + wr * 64 + fr + 16 * odd;
        const int acol0 = u.pn * 128 + wc * 16 + 4 * (fq & ~1);
#pragma unroll
        for (int ai = 0; ai < 2; ++ai)
#pragma unroll
            for (int mp = 0; mp < 2; ++mp) {
#pragma unroll
                for (int bj = 0; bj < 2; ++bj) {
                    const f32x4 g0 = acc[ai][bj][2 * mp][0], u0 = acc[ai][bj][2 * mp][1], g1 = acc[ai][bj][2 * mp + 1][0], u1 = acc[ai][bj][2 * mp + 1][1];
                    unsigned ax = cvtpk(siluf(g0[0]) * u0[0], siluf(g0[1]) * u0[1]), ay = cvtpk(siluf(g0[2]) * u0[2], siluf(g0[3]) * u0[3]);
                    unsigned bx = cvtpk(siluf(g1[0]) * u1[0], siluf(g1[1]) * u1[1]), by = cvtpk(siluf(g1[2]) * u1[2], siluf(g1[3]) * u1[3]);
                    { auto r = __builtin_amdgcn_permlane16_swap(ax, bx, false, false); ax = r[0]; bx = r[1]; }
                    { auto r = __builtin_amdgcn_permlane16_swap(ay, by, false, false); ay = r[0]; by = r[1]; }
                    u32x4 o; o.x = ax; o.y = ay; o.z = bx; o.w = by;
                    *(u32x4*)(act + (size_t)(row0 + ai * 128 + mp * 32) * DFF + acol0 + bj * 64) = o;
                }
                asm volatile("" ::: "memory");
            }
    }
};

__device__ __forceinline__ int map_row(int mapid, int n) {
    if (mapid == 1) { const int head = n / 96, w = n - head * 96; if (w < 64) return n; const int r = w - 64; const int p = (r < 16) ? 2 * r : 2 * (r - 16) + 1; return head * 96 + 64 + p; }
    if (mapid == 2) return 8 * (n >> 2) + (n & 3);
    if (mapid == 3) return 8 * (n >> 2) + 4 + (n & 3);
    return n;
}
__device__ __forceinline__ void transpose_item(const float* W, int K, int N, int Npad, bf16_t* WT, int mapid, const float* kscale, LAS float* scr, int item, int lane) {
    const int nblk = Npad / 32, kb = item / nblk, nb = item % nblk, k0 = 64 * kb, n0 = 32 * nb;
    const int nn = n0 + (lane & 31);
#pragma unroll
    for (int i = 0; i < 32; ++i) { const int kk = 2 * i + (lane >> 5); float v = 0.f; if (nn < N) { v = __builtin_nontemporal_load(W + (size_t)(k0 + kk) * N + nn); if (kscale) v *= kscale[k0 + kk]; } scr[kk * 33 + (lane & 31)] = v; }
    asm volatile("s_waitcnt lgkmcnt(0)" ::: "memory");
    const int c = lane & 7;
#pragma unroll
    for (int j = 0; j < 4; ++j) { const int n = (lane >> 3) + 8 * j; const LAS float* s = scr + (8 * c) * 33 + n;
        u32x4 o; o.x = cvtpk(s[0 * 33], s[1 * 33]); o.y = cvtpk(s[2 * 33], s[3 * 33]); o.z = cvtpk(s[4 * 33], s[5 * 33]); o.w = cvtpk(s[6 * 33], s[7 * 33]);
        const int nsrc = n0 + n; const int drow = (nsrc < N) ? map_row(mapid, nsrc) : nsrc;
        *(u32x4*)(WT + (size_t)drow * K + k0 + 8 * c) = o; }
    asm volatile("s_waitcnt lgkmcnt(0)" ::: "memory");
}

constexpr int AT_KROW = 208, AT_VROW = 144, AT_KBYTES = 64 * AT_KROW, AT_BUF = AT_KBYTES + 64 * AT_VROW;
__device__ __forceinline__ void attn_unit(LAS unsigned char* lds, const bf16_t* __restrict__ Q, const bf16_t* __restrict__ Kn, const bf16_t* __restrict__ Kr, const bf16_t* __restrict__ Vt,
                                          bf16_t* Y, const float* __restrict__ gout, const float* __restrict__ rstdq, const float* __restrict__ cosT, const float* __restrict__ sinT,
                                          int b, int hd, int qb, int wave, int lane) {
    asm volatile("" : "+v"(lane)); lane &= 63;
    const int r32 = lane & 31, hi = lane >> 5, tid = wave * 64 + lane;
    const int qrow0 = qb * 512 + wave * 64;
    bf16x8 qf[2][6];
#pragma unroll
    for (int i = 0; i < 2; ++i) {
        const int q = qrow0 + 32 * i + r32;
        const bf16_t* Qp = Q + ((size_t)((b * NH + hd) * SEQ + q)) * DQK + 8 * hi;
        const float qsc = rstdq[(size_t)b * SEQ + q] * QSCALE;
#pragma unroll
        for (int d0 = 0; d0 < 6; ++d0) {
            const u32x4 qu = *(const u32x4*)(Qp + 16 * d0);
            float e0 = bflo(qu.x) * qsc, e1 = bfhi(qu.x) * qsc, e2 = bflo(qu.y) * qsc, e3 = bfhi(qu.y) * qsc, e4 = bflo(qu.z) * qsc, e5 = bfhi(qu.z) * qsc, e6 = bflo(qu.w) * qsc, e7 = bfhi(qu.w) * qsc;
            if (d0 >= 4) {
                const int i0 = 8 * (d0 - 4) + 4 * hi;
                const f32x4 c = *(const f32x4*)(cosT + ((size_t)b * SEQ + q) * 16 + i0), sn = *(const f32x4*)(sinT + ((size_t)b * SEQ + q) * 16 + i0);
                const float t0 = e0 * c[0] - e1 * sn[0], t1 = e1 * c[0] + e0 * sn[0], t2 = e2 * c[1] - e3 * sn[1], t3 = e3 * c[1] + e2 * sn[1];
                const float t4 = e4 * c[2] - e5 * sn[2], t5 = e5 * c[2] + e4 * sn[2], t6 = e6 * c[3] - e7 * sn[3], t7 = e7 * c[3] + e6 * sn[3];
                e0 = t0; e1 = t1; e2 = t2; e3 = t3; e4 = t4; e5 = t5; e6 = t6; e7 = t7;
            }
            u32x4 o; o.x = cvtpk(e0, e1); o.y = cvtpk(e2, e3); o.z = cvtpk(e4, e5); o.w = cvtpk(e6, e7);
            qf[i][d0] = __builtin_bit_cast(bf16x8, o);
        }
    }
    const int NTL = 8 * (qb + 1), tmax = qrow0 >> 6;
    const bf16_t* gK = Kn + ((size_t)((b * NH + hd) * SEQ + (tid >> 3))) * DNOPE + (tid & 7) * 8;
    const bf16_t* gKr = Kr + ((size_t)(b * SEQ + (tid >> 2))) * DROPE + (tid & 3) * 8;
    const bf16_t* gV = Vt + (((size_t)(b * NH + hd) * (SEQ / 32) + (tid >> 8)) * DV + ((tid >> 2) & 63)) * 32 + (tid & 3) * 8;
    const unsigned lK = (tid >> 3) * AT_KROW + (tid & 7) * 16, lKr = (tid >> 2) * AT_KROW + 128 + (tid & 3) * 16;
    const unsigned lV = AT_KBYTES + ((tid >> 2) & 63) * AT_VROW + (tid >> 8) * 64 + (tid & 3) * 16;
    u32x4 sk, skr = {0u, 0u, 0u, 0u}, sv;
    sk = *(const u32x4*)gK; if (tid < 256) skr = *(const u32x4*)gKr; sv = *(const u32x4*)gV;
    *(LAS u32x4*)(lds + lK) = sk; if (tid < 256) *(LAS u32x4*)(lds + lKr) = skr; *(LAS u32x4*)(lds + lV) = sv;
    __syncthreads();
    f32x16 o[2][2];
#pragma unroll
    for (int i = 0; i < 2; ++i)
#pragma unroll
        for (int r = 0; r < 16; ++r) { o[i][0][r] = 0.f; o[i][1][r] = 0.f; }
    constexpr float ATT_THR = 8.f;
    float mref[2] = {0.f, 0.f}, lrun[2] = {0.f, 0.f};
#pragma unroll 1
    for (int t = 0; t < NTL; ++t) {
        const unsigned cur = (t & 1) * AT_BUF, nxt = AT_BUF - cur;
        if (t + 1 < NTL) {
            sk = *(const u32x4*)(gK + (size_t)(t + 1) * 64 * DNOPE); if (tid < 256) skr = *(const u32x4*)(gKr + (size_t)(t + 1) * 64 * DROPE);
            sv = *(const u32x4*)(gV + (size_t)(t + 1) * 2 * DV * 32);
        }
        if (t <= tmax) {
            const LAS unsigned char* kb = lds + cur + r32 * AT_KROW + hi * 16;
            f32x16 s[2][2];
#pragma unroll
            for (int i = 0; i < 2; ++i)
#pragma unroll
                for (int r = 0; r < 16; ++r) { s[i][0][r] = 0.f; s[i][1][r] = 0.f; }
#pragma unroll
            for (int d0 = 0; d0 < 6; ++d0) {
                const bf16x8 k0 = *(const LAS bf16x8*)(kb + d0 * 32), k1 = *(const LAS bf16x8*)(kb + 32 * AT_KROW + d0 * 32);
                s[0][0] = __builtin_amdgcn_mfma_f32_32x32x16_bf16(k0, qf[0][d0], s[0][0], 0, 0, 0);
                s[0][1] = __builtin_amdgcn_mfma_f32_32x32x16_bf16(k1, qf[0][d0], s[0][1], 0, 0, 0);
                s[1][0] = __builtin_amdgcn_mfma_f32_32x32x16_bf16(k0, qf[1][d0], s[1][0], 0, 0, 0);
                s[1][1] = __builtin_amdgcn_mfma_f32_32x32x16_bf16(k1, qf[1][d0], s[1][1], 0, 0, 0);
            }
            u32x4 p[2][4];
#pragma unroll
            for (int i = 0; i < 2; ++i) {
                f32x16 s0 = s[i][0] - mref[i], s1 = s[i][1] - mref[i];
                if (t == tmax) {
                    const int qrel = 32 * i + r32;
#pragma unroll
                    for (int r = 0; r < 16; ++r) { const int key = crow(r, hi); if (key > qrel) s0[r] = -INFINITY; if (key + 32 > qrel) s1[r] = -INFINITY; }
                }
                float mx = fmaxf(fmaxf(s0[0], s1[0]), fmaxf(s0[1], s1[1]));
#pragma unroll
                for (int r = 2; r < 16; r += 2) mx = fmaxf(fmaxf(mx, fmaxf(s0[r], s1[r])), fmaxf(s0[r + 1], s1[r + 1]));
                mx = fmaxf(mx, __shfl_xor(mx, 32));
                if (t == 0 || __any(mx > ATT_THR)) {
                    const float dl = (t == 0) ? mx : fmaxf(mx, 0.f);
                    mref[i] += dl;
                    s0 = s0 - dl; s1 = s1 - dl;
                    const float alpha = __builtin_amdgcn_exp2f(-dl);
                    lrun[i] *= alpha; o[i][0] = o[i][0] * alpha; o[i][1] = o[i][1] * alpha;
                }
#pragma unroll
                for (int r = 0; r < 16; ++r) { s0[r] = __builtin_amdgcn_exp2f(s0[r]); s1[r] = __builtin_amdgcn_exp2f(s1[r]); }
                {
                    const f32x16 ts = s0 + s1;
                    lrun[i] += ((ts[0] + ts[1]) + (ts[2] + ts[3])) + ((ts[4] + ts[5]) + (ts[6] + ts[7])) + ((ts[8] + ts[9]) + (ts[10] + ts[11])) + ((ts[12] + ts[13]) + (ts[14] + ts[15]));
                }
                p[i][0].x = cvtpk(s0[0], s0[1]); p[i][0].y = cvtpk(s0[2], s0[3]); p[i][0].z = cvtpk(s0[4], s0[5]); p[i][0].w = cvtpk(s0[6], s0[7]);
                p[i][1].x = cvtpk(s0[8], s0[9]); p[i][1].y = cvtpk(s0[10], s0[11]); p[i][1].z = cvtpk(s0[12], s0[13]); p[i][1].w = cvtpk(s0[14], s0[15]);
                p[i][2].x = cvtpk(s1[0], s1[1]); p[i][2].y = cvtpk(s1[2], s1[3]); p[i][2].z = cvtpk(s1[4], s1[5]); p[i][2].w = cvtpk(s1[6], s1[7]);
                p[i][3].x = cvtpk(s1[8], s1[9]); p[i][3].y = cvtpk(s1[10], s1[11]); p[i][3].z = cvtpk(s1[12], s1[13]); p[i][3].w = cvtpk(s1[14], s1[15]);
            }
            const LAS unsigned char* vb = lds + cur + AT_KBYTES + r32 * AT_VROW + hi * 16;
#pragma unroll
            for (int kk = 0; kk < 4; ++kk) {
                const bf16x8 v0 = *(const LAS bf16x8*)(vb + kk * 32), v1 = *(const LAS bf16x8*)(vb + 32 * AT_VROW + kk * 32);
                const bf16x8 pf0 = __builtin_bit_cast(bf16x8, p[0][kk]), pf1 = __builtin_bit_cast(bf16x8, p[1][kk]);
                o[0][0] = __builtin_amdgcn_mfma_f32_32x32x16_bf16(v0, pf0, o[0][0], 0, 0, 0);
                o[0][1] = __builtin_amdgcn_mfma_f32_32x32x16_bf16(v1, pf0, o[0][1], 0, 0, 0);
                o[1][0] = __builtin_amdgcn_mfma_f32_32x32x16_bf16(v0, pf1, o[1][0], 0, 0, 0);
                o[1][1] = __builtin_amdgcn_mfma_f32_32x32x16_bf16(v1, pf1, o[1][1], 0, 0, 0);
            }
        }
        if (t + 1 < NTL) { *(LAS u32x4*)(lds + nxt + lK) = sk; if (tid < 256) *(LAS u32x4*)(lds + nxt + lKr) = skr; *(LAS u32x4*)(lds + nxt + lV) = sv; }
        __syncthreads();
    }
#pragma unroll
    for (int i = 0; i < 2; ++i) {
        const int q = qrow0 + 32 * i + r32;
        const float ltot = lrun[i] + __shfl_xor(lrun[i], 32);
        const float inv = 1.f / ltot;
        float ssq = 0.f;
#pragma unroll
        for (int r = 0; r < 16; ++r) { o[i][0][r] *= inv; o[i][1][r] *= inv; ssq += o[i][0][r] * o[i][0][r] + o[i][1][r] * o[i][1][r]; }
        ssq += __shfl_xor(ssq, 32);
        const float rs = rsqrtf(ssq * (1.f / DV) + EPS);
        bf16_t* yp = Y + (size_t)(b * SEQ + q) * DMIX + hd * DV + 4 * hi;
        const float* gp = gout + hd * DV + 4 * hi;
#pragma unroll
        for (int g = 0; g < 4; ++g) {
            const f32x4 g0 = *(const f32x4*)(gp + 8 * g), g1 = *(const f32x4*)(gp + 32 + 8 * g);
            u32x2 w0, w1;
            w0.x = cvtpk(o[i][0][4 * g] * rs * g0[0], o[i][0][4 * g + 1] * rs * g0[1]); w0.y = cvtpk(o[i][0][4 * g + 2] * rs * g0[2], o[i][0][4 * g + 3] * rs * g0[3]);
            w1.x = cvtpk(o[i][1][4 * g] * rs * g1[0], o[i][1][4 * g + 1] * rs * g1[1]); w1.y = cvtpk(o[i][1][4 * g + 2] * rs * g1[2], o[i][1][4 * g + 3] * rs * g1[3]);
            *(u32x2*)(yp + 8 * g) = w0; *(u32x2*)(yp + 32 + 8 * g) = w1;
        }
    }
}

__device__ __forceinline__ float wave_incl_scan(float v, int lane) {
#pragma unroll
    for (int o = 1; o < 64; o <<= 1) { const float t = __shfl_up(v, o); if (lane >= o) v += t; }
    return v;
}
__device__ __forceinline__ void mlstm_chunk_state(int ch, const bf16_t* __restrict__ Z, const bf16_t* __restrict__ Km, const float* __restrict__ gates,
                                                  float* dC, float* dn, float* mloc, float* btot, int lane) {
    asm volatile("" : "+v"(lane)); lane &= 63;
    const int c = ch & 63, hh = (ch >> 6) & 3, b = ch >> 8;
    const int r32 = lane & 31, hi = lane >> 5;
    const size_t row0 = (size_t)b * SEQ + c * CHUNK;
    const float gi = gates[(row0 + lane) * 8 + hh], gf = gates[(row0 + lane) * 8 + 4 + hh];
    const float lf = logsigmoidf_(gf);
    const float bcum = wave_incl_scan(lf, lane);
    const float bt = __shfl(bcum, 63);
    const float g = bt - bcum + gi;
    const float ml = wave_max(g);
    const float wgt = __expf(g - ml);
    f32x16 acc[4][2];
#pragma unroll
    for (int vb = 0; vb < 4; ++vb)
#pragma unroll
        for (int kb = 0; kb < 2; ++kb)
#pragma unroll
            for (int r = 0; r < 16; ++r) acc[vb][kb][r] = 0.f;
    float dnp[2] = {0.f, 0.f};
    const bf16_t* Vp = Z + row0 * DINP + ZV + hh * MDV + r32;
    const bf16_t* Kp = Km + ((size_t)((b * MH + hh) * SEQ + c * CHUNK)) * MDK + r32;
#pragma unroll 2
    for (int ks = 0; ks < 4; ++ks) {
        const int l0 = 16 * ks + 8 * hi;
        float w[8];
#pragma unroll
        for (int j = 0; j < 8; ++j) w[j] = __shfl(wgt, l0 + j);
        bf16x8 bfr[2];
#pragma unroll
        for (int kb = 0; kb < 2; ++kb) {
            float kv[8];
#pragma unroll
            for (int j = 0; j < 8; ++j) { kv[j] = bf2f(Kp[(size_t)(l0 + j) * MDK + 32 * kb]) * w[j]; dnp[kb] += kv[j]; }
            u32x4 p; p.x = cvtpk(kv[0], kv[1]); p.y = cvtpk(kv[2], kv[3]); p.z = cvtpk(kv[4], kv[5]); p.w = cvtpk(kv[6], kv[7]);
            bfr[kb] = __builtin_bit_cast(bf16x8, p);
        }
#pragma unroll
        for (int vb = 0; vb < 4; ++vb) {
            bf16x8 af;
#pragma unroll
            for (int j = 0; j < 8; ++j) af[j] = (short)Vp[(size_t)(l0 + j) * DINP + 32 * vb];
            acc[vb][0] = __builtin_amdgcn_mfma_f32_32x32x16_bf16(af, bfr[0], acc[vb][0], 0, 0, 0);
            acc[vb][1] = __builtin_amdgcn_mfma_f32_32x32x16_bf16(af, bfr[1], acc[vb][1], 0, 0, 0);
        }
    }
    float* dCp = dC + (size_t)ch * (MDV * MDK);
#pragma unroll
    for (int vb = 0; vb < 4; ++vb)
#pragma unroll
        for (int kb = 0; kb < 2; ++kb)
#pragma unroll
            for (int r = 0; r < 16; ++r) dCp[(32 * vb + crow(r, hi)) * MDK + 32 * kb + r32] = acc[vb][kb][r];
#pragma unroll
    for (int kb = 0; kb < 2; ++kb) { const float t = dnp[kb] + __shfl_xor(dnp[kb], 32); if (hi == 0) dn[(size_t)ch * MDK + 32 * kb + r32] = t; }
    if (lane == 0) { mloc[ch] = ml; btot[ch] = bt; }
}

__device__ __forceinline__ float wave_incl_scan_max(float v, int lane) {
#pragma unroll
    for (int o = 1; o < 64; o <<= 1) { const float t = __shfl_up(v, o); if (lane >= o) v = fmaxf(v, t); }
    return v;
}
__device__ __forceinline__ void mlstm_chunk_out(int ch, const bf16_t* __restrict__ Z, const bf16_t* __restrict__ Qm, const bf16_t* __restrict__ Km, const float* __restrict__ gates,
                                                const bf16_t* __restrict__ C0, const float* __restrict__ n0, const float* __restrict__ m0p, const float* __restrict__ gout,
                                                bf16_t* Y, int lane) {
    asm volatile("" : "+v"(lane)); lane &= 63;
    const int c = ch & 63, hh = (ch >> 6) & 3, b = ch >> 8;
    int r32 = lane & 31, hi = lane >> 5;
    const size_t row0 = (size_t)b * SEQ + c * CHUNK;
    const float gi = gates[(row0 + lane) * 8 + hh], gf = gates[(row0 + lane) * 8 + 4 + hh];
    const float lf = logsigmoidf_(gf);
    const float bcum = wave_incl_scan(lf, lane);
    const float uu = gi - bcum;
    const float pmax = wave_incl_scan_max(uu, lane);
    const float m0 = m0p[ch];
    const bf16_t* Qb = Qm + ((size_t)((b * MH + hh) * SEQ + c * CHUNK)) * MDK;
    const bf16_t* Kb = Km + ((size_t)((b * MH + hh) * SEQ + c * CHUNK)) * MDK;
    const bf16_t* Vp = Z + row0 * DINP + ZV + hh * MDV + r32;
    const bf16_t* C0p = C0 + (size_t)ch * (MDV * MDK);
    const float* n0p = n0 + (size_t)ch * MDK;
#pragma unroll 1
    for (int tb = 0; tb < 2; ++tb) {
        asm volatile("" : "+v"(r32), "+v"(hi)); r32 &= 31; hi &= 1;
        const int t = 32 * tb + r32;
        const float bt_t = __shfl(bcum, t), pm_t = __shfl(pmax, t);
        const float mt = bt_t + fmaxf(m0, pm_t);
        const float inter = __expf(bt_t + m0 - mt);
        const float dbase = bt_t - mt;
        bf16x8 qf[4];
#pragma unroll
        for (int d0 = 0; d0 < 4; ++d0) qf[d0] = *(const bf16x8*)(Qb + (size_t)t * MDK + 16 * d0 + 8 * hi);
        float dsum = 0.f;
        bf16x8 pf[2][2];
#pragma unroll
        for (int sb = 0; sb < 2; ++sb) {
            f32x16 sT;
#pragma unroll
            for (int r = 0; r < 16; ++r) sT[r] = 0.f;
            if (sb <= tb) {
#pragma unroll
                for (int d0 = 0; d0 < 4; ++d0) {
                    const bf16x8 kfr = *(const bf16x8*)(Kb + (size_t)(32 * sb + r32) * MDK + 16 * d0 + 8 * hi);
                    sT = __builtin_amdgcn_mfma_f32_32x32x16_bf16(kfr, qf[d0], sT, 0, 0, 0);
                }
            }
            float sc[16];
#pragma unroll
            for (int r = 0; r < 16; ++r) {
                const int s = 32 * sb + crow(r, hi);
                const float us = __shfl(uu, s);
                const float d = (s <= t) ? __expf(dbase + us) : 0.f;
                sc[r] = sT[r] * d; dsum += sc[r];
            }
            u32x4 p0, p1;
            p0.x = cvtpk(sc[0], sc[1]); p0.y = cvtpk(sc[2], sc[3]); p0.z = cvtpk(sc[4], sc[5]); p0.w = cvtpk(sc[6], sc[7]);
            p1.x = cvtpk(sc[8], sc[9]); p1.y = cvtpk(sc[10], sc[11]); p1.z = cvtpk(sc[12], sc[13]); p1.w = cvtpk(sc[14], sc[15]);
            pf[sb][0] = __builtin_bit_cast(bf16x8, p0); pf[sb][1] = __builtin_bit_cast(bf16x8, p1);
        }
        dsum += __shfl_xor(dsum, 32);
        float qn = 0.f; bf16x8 qs[4];
#pragma unroll
        for (int d0 = 0; d0 < 4; ++d0) {
            const f32x4 na = *(const f32x4*)(n0p + 16 * d0 + 8 * hi), nb = *(const f32x4*)(n0p + 16 * d0 + 8 * hi + 4);
            const u32x4 qu = __builtin_bit_cast(u32x4, qf[d0]);
            const float q0 = bflo(qu.x), q1 = bfhi(qu.x), q2 = bflo(qu.y), q3 = bfhi(qu.y), q4 = bflo(qu.z), q5 = bfhi(qu.z), q6 = bflo(qu.w), q7 = bfhi(qu.w);
            qn += q0 * na[0] + q1 * na[1] + q2 * na[2] + q3 * na[3] + q4 * nb[0] + q5 * nb[1] + q6 * nb[2] + q7 * nb[3];
            u32x4 o; o.x = cvtpk(q0 * inter, q1 * inter); o.y = cvtpk(q2 * inter, q3 * inter); o.z = cvtpk(q4 * inter, q5 * inter); o.w = cvtpk(q6 * inter, q7 * inter);
            qs[d0] = __builtin_bit_cast(bf16x8, o);
        }
        qn += __shfl_xor(qn, 32);
        const float den = dsum + inter * qn;
        const float rden = 1.f / fmaxf(fabsf(den), __expf(-mt));
        const bf16_t* zo = Z + (row0 + t) * DINP + ZO + hh * MDV + 4 * hi;
        f32x16 nm[4];
        float ssq = 0.f;
#pragma unroll
        for (int vb = 0; vb < 4; ++vb) {
#pragma unroll
            for (int r = 0; r < 16; ++r) nm[vb][r] = 0.f;
#pragma unroll
            for (int d0 = 0; d0 < 4; ++d0) {
                const bf16x8 cf = *(const bf16x8*)(C0p + (size_t)(32 * vb + r32) * MDK + 16 * d0 + 8 * hi);
                nm[vb] = __builtin_amdgcn_mfma_f32_32x32x16_bf16(cf, qs[d0], nm[vb], 0, 0, 0);
            }
#pragma unroll
            for (int sb = 0; sb < 2; ++sb) {
                if (sb <= tb) {
#pragma unroll
                    for (int ks = 0; ks < 2; ++ks) {
                        bf16x8 vf;
#pragma unroll
                        for (int j = 0; j < 8; ++j) { const int s = 32 * sb + 16 * ks + 8 * (j >> 2) + 4 * hi + (j & 3); vf[j] = (short)Vp[(size_t)s * DINP + 32 * vb]; }
                        nm[vb] = __builtin_amdgcn_mfma_f32_32x32x16_bf16(vf, pf[sb][ks], nm[vb], 0, 0, 0);
                    }
                }
            }
#pragma unroll
            for (int g = 0; g < 4; ++g) {
                const u32x2 ou = *(const u32x2*)(zo + 32 * vb + 8 * g);
                const float o0 = sigmoidf_(bflo(ou.x)), o1 = sigmoidf_(bfhi(ou.x)), o2 = sigmoidf_(bflo(ou.y)), o3 = sigmoidf_(bfhi(ou.y));
                nm[vb][4 * g] *= rden * o0; nm[vb][4 * g + 1] *= rden * o1; nm[vb][4 * g + 2] *= rden * o2; nm[vb][4 * g + 3] *= rden * o3;
                ssq += nm[vb][4 * g] * nm[vb][4 * g] + nm[vb][4 * g + 1] * nm[vb][4 * g + 1] + nm[vb][4 * g + 2] * nm[vb][4 * g + 2] + nm[vb][4 * g + 3] * nm[vb][4 * g + 3];
            }
            asm volatile("" ::: "memory");
        }
        ssq += __shfl_xor(ssq, 32);
        const float rs = rsqrtf(ssq * (1.f / MDV) + EPS);
        bf16_t* yp = Y + (row0 + t) * DMIX + 512 + hh * MDV + 4 * hi;
        const float* gp = gout + hh * MDV + 4 * hi;
#pragma unroll
        for (int vb = 0; vb < 4; ++vb)
#pragma unroll
            for (int g = 0; g < 4; ++g) {
                const f32x4 gg = *(const f32x4*)(gp + 32 * vb + 8 * g);
                u32x2 w; w.x = cvtpk(nm[vb][4 * g] * rs * gg[0], nm[vb][4 * g + 1] * rs * gg[1]); w.y = cvtpk(nm[vb][4 * g + 2] * rs * gg[2], nm[vb][4 * g + 3] * rs * gg[3]);
                *(u32x2*)(yp + 32 * vb + 8 * g) = w;
            }
    }
}


#define XB_TMO      128
#define XB_XCNT(j)  (256  + 64 * (j))
#define XB_XSUB(j)  (1280 + 64 * (j))
#define XB_XGEN(j)  (2304 + 64 * (j))
#define XB_TOP      3328
#define XB_TOPGEN   3392
#define XCD_BAR_WORDS 3456
#define XB_SPIN_CAP (1u << 22)
__device__ __forceinline__ unsigned xb_ld(unsigned* p)              { return __hip_atomic_load(p, __ATOMIC_RELAXED, __HIP_MEMORY_SCOPE_AGENT); }
__device__ __forceinline__ unsigned xb_add(unsigned* p, unsigned v) { return __hip_atomic_fetch_add(p, v, __ATOMIC_RELAXED, __HIP_MEMORY_SCOPE_AGENT); }
__device__ __forceinline__ unsigned xb_xcc_id() { return (unsigned)__builtin_amdgcn_s_getreg((3 << 11) | 20) & 0xFu; }
#define XB_SPIN(cond, bar) do { unsigned _sp = 0; while (cond) { __builtin_amdgcn_s_sleep(1); \
    if ((++_sp & 255u) == 0u) { if (xb_ld(&(bar)[XB_TMO])) break; if (_sp > XB_SPIN_CAP) { atomicAdd(&(bar)[XB_TMO], 1u); break; } } } } while (0)
struct XcdBarrier { unsigned* bar; unsigned x; volatile LAS unsigned* st; };
__device__ __forceinline__ XcdBarrier xcd_barrier_post(unsigned* bar, volatile LAS unsigned* st) {
    XcdBarrier b; b.bar = bar; b.x = xb_xcc_id(); b.st = st;
    if (threadIdx.x == 0) (void)xb_add(&bar[XB_XCNT(b.x)], 1u);
    return b;
}
__device__ __forceinline__ void xcd_barrier_complete(unsigned* bar, unsigned x, unsigned& nloc, unsigned& nx) {
    const unsigned G = gridDim.x * gridDim.y * gridDim.z;
    unsigned sum, cnt, mine, sp = 0u;
    for (;;) {
        sum = 0u; cnt = 0u; mine = 0u;
#pragma unroll
        for (unsigned j = 0; j < 16; ++j) { const unsigned c = xb_ld(&bar[XB_XCNT(j)]); sum += c; cnt += (c > 0u) ? 1u : 0u; mine = (j == x) ? c : mine; }
        if (sum == G) break;
        __builtin_amdgcn_s_sleep(1);
        if ((++sp & 255u) == 0u) { if (xb_ld(&bar[XB_TMO])) break; if (sp > XB_SPIN_CAP) { atomicAdd(&bar[XB_TMO], 1u); break; } }
    }
    nloc = mine > 0u ? mine : 1u; nx = cnt > 0u ? cnt : 1u;
}
__device__ __forceinline__ void xcd_barrier(const XcdBarrier& b) {
    asm volatile("s_waitcnt vmcnt(0)" ::: "memory");
    __syncthreads();
    if (threadIdx.x == 0) {
        unsigned* bar = b.bar;
        __builtin_amdgcn_s_waitcnt(0);
        unsigned nloc = b.st[0], nx = b.st[1];
        if (nloc == 0u) { xcd_barrier_complete(bar, b.x, nloc, nx); b.st[0] = nloc; b.st[1] = nx; }
        const unsigned old = xb_add(&bar[XB_XSUB(b.x)], 1u);
        const unsigned gen = old / nloc;
        if (old + 1u == (gen + 1u) * nloc) {
            __builtin_amdgcn_fence(__ATOMIC_RELEASE, "agent");
            asm volatile("s_waitcnt vmcnt(0)" ::: "memory");
            const unsigned og = xb_add(&bar[XB_TOP], 1u);
            const unsigned tg = og / nx;
            if (og + 1u == (tg + 1u) * nx) xb_add(&bar[XB_TOPGEN], 1u);
            else XB_SPIN(xb_ld(&bar[XB_TOPGEN]) == tg, bar);
            __builtin_amdgcn_fence(__ATOMIC_ACQUIRE, "agent");
            xb_add(&bar[XB_XGEN(b.x)], 1u);
            asm volatile("s_waitcnt vmcnt(0)" ::: "memory");
        } else {
            XB_SPIN(xb_ld(&bar[XB_XGEN(b.x)]) == gen, bar);
            __builtin_amdgcn_fence(__ATOMIC_ACQUIRE, "agent");
            asm volatile("s_waitcnt vmcnt(0)" ::: "memory");
        }
    }
    __syncthreads();
}

struct Args { const void* in[22]; float* out; unsigned char* ws; };
#ifndef PHASE_MASK
#define PHASE_MASK 0xFFFF
#endif
#define PH(n) (((PHASE_MASK) >> (n)) & 1)
#ifndef DUP_MASK
#define DUP_MASK 0
#endif
#define DUP(n) (1 + (((DUP_MASK) >> (n)) & 1))
constexpr int LDS_BYTES = 147456;

__global__ void __launch_bounds__(512, 2) fwd_megakernel(Args a) {
    extern __shared__ __attribute__((aligned(16))) unsigned char lds_raw[];
    cg::grid_group grid = cg::this_grid();
    LAS unsigned char* lds = (LAS unsigned char*)lds_raw;
    const int wave = __builtin_amdgcn_readfirstlane((int)threadIdx.x >> 6);
    const int G = gridDim.x, bx = blockIdx.x;
    const int gw = bx * 8 + wave, NGW = G * 8;
    const int NT = G * 512;
#define FRESH_IDS() int lane = fresh_lane(); const int tid = wave * 64 + lane; const int gtid = bx * 512 + tid; (void)tid; (void)gtid

    const float* x = (const float*)a.in[0]; const float* cvec = (const float*)a.in[1]; const int* positions = (const int*)a.in[2];
    const float* w_ada = (const float*)a.in[3]; const float* b_ada = (const float*)a.in[4]; const float* g_mix = (const float*)a.in[5];
    const float* w_in = (const float*)a.in[6]; const float* g_q = (const float*)a.in[7]; const float* w_uq = (const float*)a.in[8];
    const float* g_kv = (const float*)a.in[9]; const float* w_ukv = (const float*)a.in[10]; const float* conv_w = (const float*)a.in[11];
    const float* conv_b = (const float*)a.in[12]; const float* b_gates = (const float*)a.in[13]; const float* g_out_mla = (const float*)a.in[14];
    const float* g_out_mlstm = (const float*)a.in[15]; const float* w_out = (const float*)a.in[16]; const float* g_ffn = (const float*)a.in[17];
    const float* w_gate = (const float*)a.in[18]; const float* w_up = (const float*)a.in[19]; const float* w_down = (const float*)a.in[20];
    const float* g_final = (const float*)a.in[21];
    float* out = a.out; unsigned char* ws = a.ws;
    float* mod = (float*)(ws + WS_MOD); float* cosT = (float*)(ws + WS_COS); float* sinT = (float*)(ws + WS_SIN);
    float* rstdq = (float*)(ws + WS_RSTDQ); float* rstdkv = (float*)(ws + WS_RSTDKV); float* gates = (float*)(ws + WS_GATES);
    float* mloc = (float*)(ws + WS_MLOC); float* btot = (float*)(ws + WS_BTOT); float* m0buf = (float*)(ws + WS_M0);
    float* dn = (float*)(ws + WS_DN); float* n0buf = (float*)(ws + WS_N0);
    bf16_t* Bin = (bf16_t*)(ws + WS_BIN); bf16_t* Bq = (bf16_t*)(ws + WS_BQ); bf16_t* Bkv = (bf16_t*)(ws + WS_BKV); bf16_t* Bout = (bf16_t*)(ws + WS_BOUT);
    bf16_t* Bgu = (bf16_t*)(ws + WS_BGU); bf16_t* Bd = (bf16_t*)(ws + WS_BD); bf16_t* Krope = (bf16_t*)(ws + WS_KROPE);
    bf16_t* HN = (bf16_t*)(ws + WS_HN); bf16_t* Z = (bf16_t*)(ws + WS_Z); bf16_t* Qb = (bf16_t*)(ws + WS_Q); bf16_t* Kn = (bf16_t*)(ws + WS_KN);
    bf16_t* Vt = (bf16_t*)(ws + WS_VT); bf16_t* Qm = (bf16_t*)(ws + WS_QM); bf16_t* Km = (bf16_t*)(ws + WS_KM);
    bf16_t* XG = (bf16_t*)(ws + WS_XG);
    float* dC = (float*)(ws + WS_DC); bf16_t* C0 = (bf16_t*)(ws + WS_C0); bf16_t* ACT = (bf16_t*)(ws + WS_ACT);

    unsigned* barw = (unsigned*)(ws + WS_BARW);
    volatile LAS unsigned* bst = (volatile LAS unsigned*)(lds + 131072 + 512);
    if (threadIdx.x < 2) bst[threadIdx.x] = 0u;
    __syncthreads();
    if (G == 0x7fffffff) grid.sync();
    const XcdBarrier xbar = xcd_barrier_post(barw, bst);
    if constexpr (PH(0)) _Pragma("unroll") for (int rep_ = 0; rep_ < DUP(0); ++rep_) {
        FRESH_IDS();
        LAS float* sc = (LAS float*)lds;
        LAS float* part = (LAS float*)(lds + 32768);
        if (bx < 192) {
            for (int i = tid; i < NB * DM; i += 512) sc[i] = siluf(cvec[i]);
            __syncthreads();
            const int col = tid & 31, ks = tid >> 5, n0 = 32 * bx;
            float acc[8];
#pragma unroll
            for (int b = 0; b < 8; ++b) acc[b] = 0.f;
#pragma unroll 16
            for (int kk = 0; kk < 64; ++kk) { const int k = ks * 64 + kk; const float w = __builtin_nontemporal_load(w_ada + (size_t)k * 6144 + n0 + col);
#pragma unroll
                for (int b = 0; b < 8; ++b) acc[b] += sc[b * DM + k] * w; }
#pragma unroll
            for (int b = 0; b < 8; ++b) part[(ks * 8 + b) * 32 + col] = acc[b];
            __syncthreads();
            if (tid < 256) { const int b = tid >> 5; float s = b_ada[n0 + col];
#pragma unroll
                for (int k2 = 0; k2 < 16; ++k2) s += part[(k2 * 8 + b) * 32 + col];
                mod[b * 6144 + n0 + col] = s; }
            __syncthreads();
        }
        if (gtid < 256) ((unsigned*)(ws + WS_PCNT))[gtid] = 0u;
        for (int idx = gtid; idx < MROWS * 16; idx += NT) {
            const int row = idx >> 4, i = idx & 15;
            const float inv = powf(10000.f, -(float)i / 16.f);
            const float ang = (float)positions[row] * inv;
            float sn, cs; sincosf(ang, &sn, &cs);
            cosT[idx] = cs; sinT[idx] = sn;
        }
        LAS float* scr = (LAS float*)(lds + wave * 16384);
        constexpr int I_IN = 16 * 72, I_Q = 6 * 24, I_KV = 4 * 32, I_OUT = 16 * 32, I_G = 16 * 88, I_D = 44 * 32;
        constexpr int NITEMS = I_IN + I_Q + I_KV + I_OUT + 2 * I_G + I_D;
        for (int it = gw; it < NITEMS; it += NGW) {
            int r = it;
            if (r < I_IN) { transpose_item(w_in, 1024, DIN, DINP, Bin, 0, nullptr, scr, r, lane); continue; } r -= I_IN;
            if (r < I_Q) { transpose_item(w_uq, QRANK, 768, 768, Bq, 1, g_q, scr, r, lane); continue; } r -= I_Q;
            if (r < I_KV) { transpose_item(w_ukv, KVRANK, 1024, 1024, Bkv, 0, g_kv, scr, r, lane); continue; } r -= I_KV;
            if (r < I_OUT) { transpose_item(w_out, 1024, 1024, 1024, Bout, 0, nullptr, scr, r, lane); continue; } r -= I_OUT;
            if (r < I_G) { transpose_item(w_gate, 1024, DFF, DFF, Bgu, 2, nullptr, scr, r, lane); continue; } r -= I_G;
            if (r < I_G) { transpose_item(w_up, 1024, DFF, DFF, Bgu, 3, nullptr, scr, r, lane); continue; } r -= I_G;
            transpose_item(w_down, DFF, 1024, 1024, Bd, 0, nullptr, scr, r, lane);
        }
        if constexpr (DUP(0) == 2) __syncthreads();
    }
    xcd_barrier(xbar);

    if constexpr (PH(1)) _Pragma("unroll") for (int rep_ = 0; rep_ < DUP(1); ++rep_) { FRESH_IDS(); for (int row = gw; row < MROWS; row += NGW) {
        const int b = row >> 12;
        const f32x4* xr = (const f32x4*)(x + (size_t)row * DM) + lane;
        f32x4 v[4]; float s = 0.f;
#pragma unroll
        for (int j = 0; j < 4; ++j) { v[j] = __builtin_nontemporal_load(xr + 64 * j); s += v[j][0] * v[j][0] + v[j][1] * v[j][1] + v[j][2] * v[j][2] + v[j][3] * v[j][3]; }
        const float rstd = rsqrtf(wave_sum(s) * (1.f / DM) + EPS);
        unsigned long long* o8 = (unsigned long long*)(HN + (size_t)row * DM) + lane;
#pragma unroll
        for (int j = 0; j < 4; ++j) {
            const int col = 4 * lane + 256 * j;
            const f32x4 g = *(const f32x4*)(g_mix + col), sh = *(const f32x4*)(mod + b * 6144 + col), sc = *(const f32x4*)(mod + b * 6144 + 1024 + col);
            const f32x4 h = (v[j] * rstd * g) * (sc + 1.f) + sh;
            o8[64 * j] = (unsigned long long)cvtpk(h[0], h[1]) | ((unsigned long long)cvtpk(h[2], h[3]) << 32);
        }
    } }
    xcd_barrier(xbar);

    if constexpr (PH(2)) _Pragma("unroll") for (int rep_ = 0; rep_ < DUP(2); ++rep_) {
        pg8::Gemm g{HN, Bin, MROWS, DINP, 1024, 1024}; pg8::StaticOrder S; S.init(MROWS, DINP, G, bx);
        EpiIn E{Z, gates, b_gates};
        pg8::gemm_phase<EpiIn, true>(lds, g, S, E, wave);
    }
    xcd_barrier(xbar);

    if constexpr (PH(3)) _Pragma("unroll") for (int rep_ = 0; rep_ < DUP(3); ++rep_) { FRESH_IDS();
      for (int rowb = gw * 16; rowb < MROWS; rowb += NGW * 16) {
        const int b = rowb >> 12, sb = rowb & 4095;
        const int ch0 = 8 * lane;
        f32x4 cw[4][2];
#pragma unroll
        for (int w = 0; w < 4; ++w) { cw[w][0] = *(const f32x4*)(conv_w + w * 512 + ch0); cw[w][1] = *(const f32x4*)(conv_w + w * 512 + ch0 + 4); }
        const f32x4 cb0 = *(const f32x4*)(conv_b + ch0), cb1 = *(const f32x4*)(conv_b + ch0 + 4);
        const float mul = (lane < 32) ? 1.f : 0.125f;
        const int chh = ch0 & 255, hh = chh >> 6, d = chh & 63;
        u32x4 win[3];
#pragma unroll
        for (int w = 0; w < 3; ++w) win[w] = (sb - 3 + w >= 0) ? *(const u32x4*)(Z + (size_t)(rowb - 3 + w) * DINP + ZQK + ch0) : (u32x4){0u, 0u, 0u, 0u};
#pragma unroll 2
        for (int k = 0; k < 16; ++k) {
            const int row = rowb + k, s = sb + k;
            const bf16_t* zr = Z + (size_t)row * DINP;
            const u32x4 cur = *(const u32x4*)(zr + ZQK + ch0);
            float sq = 0.f, skv = 0.f;
            if (lane < 48) { const u32x4 u = *(const u32x4*)(zr + ZQ + 8 * lane);
                const float e0 = bflo(u.x), e1 = bfhi(u.x), e2 = bflo(u.y), e3 = bfhi(u.y), e4 = bflo(u.z), e5 = bfhi(u.z), e6 = bflo(u.w), e7 = bfhi(u.w);
                sq = e0 * e0 + e1 * e1 + e2 * e2 + e3 * e3 + e4 * e4 + e5 * e5 + e6 * e6 + e7 * e7; }
            if (lane < 32) { const u32x4 u = *(const u32x4*)(zr + ZKV + 8 * lane);
                const float e0 = bflo(u.x), e1 = bfhi(u.x), e2 = bflo(u.y), e3 = bfhi(u.y), e4 = bflo(u.z), e5 = bfhi(u.z), e6 = bflo(u.w), e7 = bfhi(u.w);
                skv = e0 * e0 + e1 * e1 + e2 * e2 + e3 * e3 + e4 * e4 + e5 * e5 + e6 * e6 + e7 * e7; }
            sq = wave_sum(sq); skv = wave_sum(skv);
            if (lane == 0) { rstdq[row] = rsqrtf(sq * (1.f / QRANK) + EPS); rstdkv[row] = rsqrtf(skv * (1.f / KVRANK) + EPS); }
            if (lane < 16) {
                const float x1 = bf2f(zr[ZKR + lane]), x2 = bf2f(zr[ZKR + 16 + lane]);
                const float cs = cosT[row * 16 + lane], sn = sinT[row * 16 + lane];
                *(unsigned*)(Krope + (size_t)row * DROPE + 2 * lane) = cvtpk(x1 * cs - x2 * sn, x2 * cs + x1 * sn);
            }
            float acc[8] = {cb0[0], cb0[1], cb0[2], cb0[3], cb1[0], cb1[1], cb1[2], cb1[3]};
#pragma unroll
            for (int w = 0; w < 4; ++w) {
                const u32x4 u = (w < 3) ? win[w] : cur;
                acc[0] += bflo(u.x) * cw[w][0][0]; acc[1] += bfhi(u.x) * cw[w][0][1]; acc[2] += bflo(u.y) * cw[w][0][2]; acc[3] += bfhi(u.y) * cw[w][0][3];
                acc[4] += bflo(u.z) * cw[w][1][0]; acc[5] += bfhi(u.z) * cw[w][1][1]; acc[6] += bflo(u.w) * cw[w][1][2]; acc[7] += bfhi(u.w) * cw[w][1][3];
            }
            win[0] = win[1]; win[1] = win[2]; win[2] = cur;
#pragma unroll
            for (int j = 0; j < 8; ++j) acc[j] = siluf(acc[j]) * mul;
            u32x4 o; o.x = cvtpk(acc[0], acc[1]); o.y = cvtpk(acc[2], acc[3]); o.z = cvtpk(acc[4], acc[5]); o.w = cvtpk(acc[6], acc[7]);
            bf16_t* dst = ((lane < 32) ? Qm : Km) + ((size_t)((b * MH + hh) * SEQ + s)) * MDK + d;
            *(u32x4*)dst = o;
        }
      } }
    xcd_barrier(xbar);

    if constexpr (PH(12)) _Pragma("unroll") for (int rep_ = 0; rep_ < DUP(12); ++rep_) { FRESH_IDS(); for (int ch = gw; ch < NCH_TOT; ch += NGW) mlstm_chunk_state(ch, Z, Km, gates, dC, dn, mloc, btot, lane); }
    __syncthreads();
    if constexpr (PH(4)) _Pragma("unroll") for (int rep_ = 0; rep_ < DUP(4); ++rep_) {
        pg8::Gemm g{Z + ZQ, Bq, MROWS, 768, QRANK, DINP}; pg8::StaticOrder S; S.init(MROWS, 768, G, bx);
        EpiQ E{Qb};
        pg8::gemm_phase<EpiQ, true>(lds, g, S, E, wave);
    }
    if constexpr (PH(14)) _Pragma("unroll") for (int rep_ = 0; rep_ < DUP(14); ++rep_) {
        pg8::Gemm g{Z + ZKV, Bkv, MROWS, 1024, KVRANK, DINP}; pg8::StaticOrder S; S.init(MROWS, 1024, G, bx);
        EpiKV E{Kn, Vt, rstdkv};
        pg8::gemm_phase<EpiKV, true>(lds, g, S, E, wave);
    }
    xcd_barrier(xbar);

    {
        const int vcu = (G % 8 == 0) ? (bx % 8) * (G / 8) + bx / 8 : bx;
        if constexpr (PH(5)) _Pragma("unroll") for (int rep_ = 0; rep_ < DUP(5); ++rep_) { FRESH_IDS(); for (int v = vcu; v < 256; v += G) {
            const int bh = v >> 2, sidx = v & 3;
#pragma unroll 1
            for (int i = 0; i < 2; ++i) {
                const int qb = (i == 0) ? sidx : 7 - sidx;
                attn_unit(lds, Qb, Kn, Krope, Vt, HN, g_out_mla, rstdq, cosT, sinT, bh >> 3, bh & 7, qb, wave, lane);
            }
        } }
        if constexpr (PH(13)) _Pragma("unroll") for (int rep_ = 0; rep_ < DUP(13); ++rep_) { FRESH_IDS();
          for (int g0 = bx * 512; g0 < NB * MH * 4096; g0 += NT) {
            const int bh = g0 >> 12, p = (g0 & 4095) + tid;
            float m = 0.f, ca = 0.f, cb = 0.f, na = 0.f, nb = 0.f;
#pragma unroll 1
            for (int c0 = 0; c0 < NCHUNK; c0 += 16) {
                f32x2_t d[16], dd[16]; float ml[16], bt[16];
#pragma unroll
                for (int j = 0; j < 16; ++j) {
                    const int ch = bh * NCHUNK + c0 + j;
                    d[j] = *(const f32x2_t*)(dC + (size_t)ch * 8192 + 2 * p);
                    dd[j] = (p < 32) ? *(const f32x2_t*)(dn + (size_t)ch * 64 + 2 * p) : (f32x2_t){0.f, 0.f};
                    ml[j] = mloc[ch]; bt[j] = btot[ch];
                }
#pragma unroll
                for (int j = 0; j < 16; ++j) {
                    const int ch = bh * NCHUNK + c0 + j;
                    *(unsigned*)(C0 + (size_t)ch * 8192 + 2 * p) = cvtpk(ca, cb);
                    if (p < 32) { *(f32x2_t*)(n0buf + (size_t)ch * 64 + 2 * p) = (f32x2_t){na, nb}; if (p == 0) m0buf[ch] = m; }
                    const float mnew = fmaxf(bt[j] + m, ml[j]);
                    const float av = __expf(bt[j] + m - mnew), ev = __expf(ml[j] - mnew);
                    na = av * na + ev * dd[j][0]; nb = av * nb + ev * dd[j][1];
                    ca = av * ca + ev * d[j][0]; cb = av * cb + ev * d[j][1];
                    m = mnew;
                }
            }
          }
        }
    }
    xcd_barrier(xbar);

    if constexpr (PH(6)) _Pragma("unroll") for (int rep_ = 0; rep_ < DUP(6); ++rep_) { FRESH_IDS(); for (int ch = gw; ch < NCH_TOT; ch += NGW) mlstm_chunk_out(ch, Z, Qm, Km, gates, C0, n0buf, m0buf, g_out_mlstm, HN, lane); }
    xcd_barrier(xbar);

    if (G == 256) {
        pg8::Gemm g{HN, Bout, MROWS, 1024, 1024, 1024}; pg8::StaticOrder S; S.init(MROWS, 1024, G, bx);
        EpiOutNorm E{x, out, mod + 2048, g_ffn, mod, XG, (float*)(ws + WS_XBUF2), (unsigned*)(ws + WS_PCNT) + 128, lds + 131072 + 2048};
        pg8::gemm_phase<EpiOutNorm, true>(lds, g, S, E, wave);
    } else {
    if constexpr (PH(7)) _Pragma("unroll") for (int rep_ = 0; rep_ < DUP(7); ++rep_) {
        pg8::Gemm g{HN, Bout, MROWS, 1024, 1024, 1024}; pg8::StaticOrder S; S.init(MROWS, 1024, G, bx);
        EpiRes E{x, out, mod + 2048};
        pg8::gemm_phase<EpiRes, true>(lds, g, S, E, wave);
    }
    xcd_barrier(xbar);

    if constexpr (PH(8)) _Pragma("unroll") for (int rep_ = 0; rep_ < DUP(8); ++rep_) { FRESH_IDS(); for (int row = gw; row < MROWS; row += NGW) {
        const int b = row >> 12;
        const f32x4* xr = (const f32x4*)(out + (size_t)row * DM) + lane;
        f32x4 v[4]; float s = 0.f;
#pragma unroll
        for (int j = 0; j < 4; ++j) { v[j] = __builtin_nontemporal_load(xr + 64 * j); s += v[j][0] * v[j][0] + v[j][1] * v[j][1] + v[j][2] * v[j][2] + v[j][3] * v[j][3]; }
        const float rstd = rsqrtf(wave_sum(s) * (1.f / DM) + EPS);
        unsigned long long* o8 = (unsigned long long*)(XG + (size_t)row * DM) + lane;
#pragma unroll
        for (int j = 0; j < 4; ++j) {
            const int col = 4 * lane + 256 * j;
            const f32x4 g = *(const f32x4*)(g_ffn + col), sh = *(const f32x4*)(mod + b * 6144 + 3072 + col), sc = *(const f32x4*)(mod + b * 6144 + 4096 + col);
            const f32x4 h = (v[j] * rstd * g) * (sc + 1.f) + sh;
            o8[64 * j] = (unsigned long long)cvtpk(h[0], h[1]) | ((unsigned long long)cvtpk(h[2], h[3]) << 32);
        }
    } }
        }
    xcd_barrier(xbar);

    if constexpr (PH(9)) _Pragma("unroll") for (int rep_ = 0; rep_ < DUP(9); ++rep_) {
        pg8::Gemm g{XG, Bgu, MROWS, 2 * DFF, 1024, 1024}; pg8::StaticOrder S; S.init(MROWS, 2 * DFF, G, bx);
        EpiGU E{ACT};
        pg8::gemm_phase<EpiGU, true>(lds, g, S, E, wave);
    }
    xcd_barrier(xbar);

    if constexpr (DUP(10) == 2) {
        pg8::Gemm g{ACT, Bd, MROWS, 1024, DFF, DFF}; pg8::StaticOrder S; S.init(MROWS, 1024, G, bx);
        EpiRes E{out, (float*)(ws + 288 * MiB), mod + 5120};
        pg8::gemm_phase<EpiRes, true>(lds, g, S, E, wave);
    }
    if (G == 256) {
        pg8::Gemm g{ACT, Bd, MROWS, 1024, DFF, DFF}; pg8::StaticOrder S; S.init(MROWS, 1024, G, bx);
        EpiResNorm E{out, out, mod + 5120, g_final, (float*)(ws + WS_XBUF), (unsigned*)(ws + WS_PCNT), lds + 131072 + 2048};
        pg8::gemm_phase<EpiResNorm, true>(lds, g, S, E, wave);
    } else {
        {
            pg8::Gemm g{ACT, Bd, MROWS, 1024, DFF, DFF}; pg8::StaticOrder S; S.init(MROWS, 1024, G, bx);
            EpiRes E{out, out, mod + 5120};
            pg8::gemm_phase<EpiRes, true>(lds, g, S, E, wave);
        }
        xcd_barrier(xbar);
        { FRESH_IDS(); for (int row = gw; row < MROWS; row += NGW) {
            f32x4* xr = (f32x4*)(out + (size_t)row * DM) + lane;
            f32x4 v[4]; float s = 0.f;
#pragma unroll
            for (int j = 0; j < 4; ++j) { v[j] = xr[64 * j]; s += v[j][0] * v[j][0] + v[j][1] * v[j][1] + v[j][2] * v[j][2] + v[j][3] * v[j][3]; }
            const float rstd = rsqrtf(wave_sum(s) * (1.f / DM) + EPS);
#pragma unroll
            for (int j = 0; j < 4; ++j) { const f32x4 g = *(const f32x4*)(g_final + 4 * lane + 256 * j); xr[64 * j] = v[j] * rstd * g; }
        } }
    }
}

extern "C" void kernel_launch(void* const* d_in, const int* in_sizes, int n_in, void* d_out, int out_size, void* d_ws, size_t ws_size, hipStream_t stream) {
    static int grid_blocks = 0;
    if (grid_blocks == 0) {
        if (n_in != 22 || ws_size < WS_END) { fprintf(stderr, "kernel_launch: unexpected n_in %d / ws_size %zu (need %zu)\n", n_in, ws_size, (size_t)WS_END); grid_blocks = -1; return; }
        int dev = 0, cus = 0, per_cu = 0;
        hipGetDevice(&dev);
        hipDeviceGetAttribute(&cus, hipDeviceAttributeMultiprocessorCount, dev);
        if (hipFuncSetAttribute((const void*)fwd_megakernel, hipFuncAttributeMaxDynamicSharedMemorySize, LDS_BYTES) != hipSuccess) fprintf(stderr, "kernel_launch: hipFuncSetAttribute failed\n");
        if (hipOccupancyMaxActiveBlocksPerMultiprocessor(&per_cu, (const void*)fwd_megakernel, 512, LDS_BYTES) != hipSuccess || per_cu < 1) { fprintf(stderr, "kernel_launch: occupancy query gave %d\n", per_cu); per_cu = 1; }
        (void)hipGetLastError();
        grid_blocks = cus;
        if (grid_blocks > 256) grid_blocks = 256;
    }
    if (grid_blocks < 0) return;
    Args a{};
    for (int i = 0; i < 22; ++i) a.in[i] = d_in[i];
    a.out = (float*)d_out; a.ws = (unsigned char*)d_ws;
    if (hipMemsetAsync((unsigned char*)d_ws + WS_BARW, 0, XCD_BAR_WORDS * 4, stream) != hipSuccess) { fprintf(stderr, "kernel_launch: memset of the barrier words failed\n"); return; }
    void* args[] = {&a};
    hipError_t e = hipLaunchCooperativeKernel((const void*)fwd_megakernel, dim3(grid_blocks), dim3(512), args, LDS_BYTES, stream);
    if (e != hipSuccess) fprintf(stderr, "cooperative launch failed: %s (grid %d)\n", hipGetErrorString(e), grid_blocks);
}
```

```cpp
#include <hip/hip_runtime.h>
#include <hip/hip_cooperative_groups.h>
#include <cstdio>
#include <cstdint>
namespace cg = cooperative_groups;

#define LAS __attribute__((address_space(3)))
typedef unsigned short bf16_t;
typedef short bf16x8 __attribute__((ext_vector_type(8)));
typedef short s16x4 __attribute__((ext_vector_type(4)));
typedef float f32x4 __attribute__((ext_vector_type(4)));
typedef float f32x16 __attribute__((ext_vector_type(16)));
typedef unsigned u32x4 __attribute__((ext_vector_type(4)));
typedef unsigned u32x2 __attribute__((ext_vector_type(2)));
typedef float f32x2_t __attribute__((ext_vector_type(2)));
typedef __bf16 bf16x2_t __attribute__((ext_vector_type(2)));

constexpr int NB = 8, SEQ = 4096, DM = 1024, MROWS = NB * SEQ;
constexpr int NH = 8, DQK = 96, DNOPE = 64, DROPE = 32, DV = 64, QRANK = 384, KVRANK = 256;
constexpr int MH = 4, MDK = 64, MDV = 128, CHUNK = 64, NCHUNK = SEQ / CHUNK, NCH_TOT = NB * MH * NCHUNK;
constexpr int DIN = 2216, DINP = 2304, DFF = 2816, DMIX = 1024;
constexpr int ZQ = 0, ZKV = 384, ZKR = 640, ZQK = 672, ZV = 1184, ZO = 1696, ZI = 2208;
constexpr float EPS = 1e-6f;
constexpr float QSCALE = 0.10206207261596575f * 1.4426950408889634f;

constexpr size_t MiB = 1u << 20;
constexpr size_t WS_MOD = 0, WS_COS = 1 * MiB, WS_SIN = 3 * MiB, WS_RSTDQ = 5 * MiB, WS_RSTDKV = 5 * MiB + 256 * 1024;
constexpr size_t WS_GATES = 6 * MiB, WS_MLOC = 7 * MiB, WS_BTOT = 7 * MiB + 64 * 1024, WS_M0 = 7 * MiB + 128 * 1024;
constexpr size_t WS_BARW = 9 * MiB + 512 * 1024;
constexpr size_t WS_PCNT = 9 * MiB + 768 * 1024;
constexpr size_t WS_XBUF = 10 * MiB;
constexpr size_t WS_DN = 8 * MiB, WS_N0 = 8 * MiB + 512 * 1024;
constexpr size_t WS_BIN = 16 * MiB, WS_BQ = 21 * MiB, WS_BKV = 22 * MiB, WS_BOUT = 23 * MiB, WS_BGU = 25 * MiB, WS_BD = 36 * MiB;
constexpr size_t WS_KROPE = 42 * MiB;
constexpr size_t WS_HN = 48 * MiB;
constexpr size_t WS_Z = 112 * MiB;
constexpr size_t WS_Q = 256 * MiB, WS_KN = 304 * MiB, WS_VT = 336 * MiB, WS_QM = 368 * MiB, WS_KM = 384 * MiB;
constexpr size_t WS_DC = 400 * MiB, WS_C0 = 464 * MiB, WS_END = 496 * MiB;
constexpr size_t WS_ACT = 112 * MiB;

__device__ __forceinline__ unsigned cvtpk(float lo, float hi) { f32x2_t v = {lo, hi}; bf16x2_t b = __builtin_convertvector(v, bf16x2_t); return __builtin_bit_cast(unsigned, b); }
__device__ __forceinline__ float bf2f(unsigned short u) { return __uint_as_float(((unsigned)u) << 16); }
__device__ __forceinline__ float bflo(unsigned u) { return __uint_as_float(u << 16); }
__device__ __forceinline__ float bfhi(unsigned u) { return __uint_as_float(u & 0xffff0000u); }
__device__ __forceinline__ unsigned short f2bf(float f) { return (unsigned short)(cvtpk(f, 0.f) & 0xffffu); }
template <int CTRL> __device__ __forceinline__ float dpp_f(float v) { return __uint_as_float((unsigned)__builtin_amdgcn_update_dpp(0, (int)__float_as_uint(v), CTRL, 0xF, 0xF, true)); }
__device__ __forceinline__ float wave_sum(float v) {
    v += dpp_f<0xB1>(v);
    v += dpp_f<0x4E>(v);
    v += dpp_f<0x141>(v);
    v += dpp_f<0x140>(v);
    { const auto r = __builtin_amdgcn_permlane16_swap(__float_as_uint(v), __float_as_uint(v), false, false); v = __uint_as_float(r[0]) + __uint_as_float(r[1]); }
    { const auto r = __builtin_amdgcn_permlane32_swap(__float_as_uint(v), __float_as_uint(v), false, false); v = __uint_as_float(r[0]) + __uint_as_float(r[1]); }
    return v;
}
__device__ __forceinline__ float wave_max(float v) {
#pragma unroll
    for (int o = 1; o < 64; o <<= 1) v = fmaxf(v, __shfl_xor(v, o));
    return v;
}
__device__ __forceinline__ int fresh_lane() { int l; asm volatile("v_mbcnt_lo_u32_b32 %0, -1, 0\n\tv_mbcnt_hi_u32_b32 %0, -1, %0" : "=v"(l)); return l & 63; }
__device__ __forceinline__ int crow(int r, int hi) { return (r & 3) + 8 * (r >> 2) + 4 * hi; }
__device__ __forceinline__ float siluf(float x) { return x * __builtin_amdgcn_rcpf(1.f + __expf(-x)); }
__device__ __forceinline__ float sigmoidf_(float x) { return __builtin_amdgcn_rcpf(1.f + __expf(-x)); }
__device__ __forceinline__ float logsigmoidf_(float x) { return fminf(x, 0.f) - log1pf(expf(-fabsf(x))); }

namespace pg8 {
constexpr int BM = 256, BK = 64, HALF = 128, HTB = HALF * BK * 2, STAGE_BYTES = 8 * HTB, NXCD = 8, WGM = 8;
__host__ __device__ __forceinline__ int lds_byte(int r, int c) { const int st = (r >> 4) * 2 + (c >> 5), rr = r & 15, cc = c & 31, ob = rr * 64 + cc * 2; return st * 1024 + (ob ^ (((ob >> 9) & 1) << 5)); }
__host__ __device__ __forceinline__ void stage_rc(int b, int& R, int& C) { const int st = b / 1024, sb = b % 1024, swz = sb ^ (((sb >> 9) & 1) << 5); R = (st >> 1) * 16 + swz / 64; C = (st & 1) * 32 + (swz % 64) / 2; }
__host__ __device__ __forceinline__ int perm32(int rho) { const int n = rho >> 4, i = rho & 15; return 8 * (i >> 2) + 4 * n + (i & 3); }
struct Unit { int pm, pn; };
struct Gemm { const bf16_t* A; const bf16_t* Bt; int M, N, K, lda; };
struct StaticOrder {
    int nM, nN, nwg, G, c;
    __device__ void init(int M, int N, int G_, int c_) { nM = M / BM; nN = N / BM; nwg = nM * nN; G = G_; c = c_; }
    __device__ bool next(int i, Unit& u) const {
        const long L = (long)i * G + c; if (L >= nwg) return false;
        int wgid = (int)L; { const int q = nwg / NXCD, r = nwg % NXCD, xcd = wgid % NXCD, off = wgid / NXCD; wgid = (xcd < r ? xcd * (q + 1) : r * (q + 1) + (xcd - r) * q) + off; }
        const int nig = WGM * nN, gid = wgid / nig, fm = gid * WGM, gsz = (nM - fm) < WGM ? (nM - fm) : WGM;
        u.pm = fm + ((wgid % nig) % gsz); u.pn = (wgid % nig) / gsz; return true;
    }
};
struct NoHook { __device__ __forceinline__ void operator()(const Unit&, int) const {} };
template <class Epi, bool ALIGN_EPI, class Hook = NoHook>
__device__ __forceinline__ void gemm_phase(LAS unsigned char* lds, const Gemm g, const StaticOrder& S, const Epi& E, const int wave_id, const Hook& H = Hook()) {
    const int lane = fresh_lane();
    const int wid = wave_id, tid = wid * 64 + lane, wr = wid >> 2, wc = wid & 3, fr = lane & 15, fq = lane >> 4;
    const int K = g.K, nt = K / BK, lda = g.lda;
    unsigned voffA[2], voffB[2];
#pragma unroll
    for (int i = 0; i < 2; ++i) { int R, C; stage_rc(tid * 16 + i * 8192, R, C); const int Rb = (R & ~31) + perm32(R & 31);
        voffA[i] = (unsigned)(R * lda + C) * 2u; voffB[i] = (unsigned)(Rb * K + C) * 2u; }
    const size_t kstep = (size_t)(BK * 2);
    const size_t hstepA = (size_t)HALF * lda * 2, hstepB = (size_t)HALF * K * 2;
    const size_t tstepA = 2 * hstepA, tstepB = 2 * hstepB;
    const unsigned ldsw = (unsigned)wid * 1024u;
    const int aoff = lds_byte(wr * 64 + fr, fq * 8), boff = lds_byte(wc * 32 + fr, fq * 8);
#define PG8_SA(b, h) (((b) * 2 + (h)) * HTB)
#define PG8_SB(b, h) ((4 + (b) * 2 + (h)) * HTB)
#define PG8_STAGE(bufoff, gbase, voff) do { _Pragma("unroll") for (int _i = 0; _i < 2; ++_i) \
        __builtin_amdgcn_global_load_lds((const unsigned*)((const char*)(gbase) + (voff)[_i]), (LAS unsigned*)(lds + (bufoff) + ldsw + _i * 8192), 16, 0, 0); } while (0)
#define PG8_LDA(dst, b, h) do { _Pragma("unroll") for (int m = 0; m < 4; ++m) _Pragma("unroll") for (int k = 0; k < 2; ++k) dst[m][k] = *(const LAS bf16x8*)(lds + PG8_SA(b, h) + aoff + m * 2048 + k * 1024); } while (0)
#define PG8_LDB(dst, b, h) do { _Pragma("unroll") for (int n = 0; n < 2; ++n) _Pragma("unroll") for (int k = 0; k < 2; ++k) dst[n][k] = *(const LAS bf16x8*)(lds + PG8_SB(b, h) + boff + n * 2048 + k * 1024); } while (0)
#define PG8_MMA(ai, bj, At, Bt) do { __builtin_amdgcn_s_setprio(1); _Pragma("unroll") for (int m = 0; m < 4; ++m) _Pragma("unroll") for (int n = 0; n < 2; ++n) _Pragma("unroll") for (int k = 0; k < 2; ++k) \
        acc[ai][bj][m][n] = __builtin_amdgcn_mfma_f32_16x16x32_bf16(Bt[n][k], At[m][k], acc[ai][bj][m][n], 0, 0, 0); __builtin_amdgcn_s_setprio(0); } while (0)
#define PG8_WAIT_V(n) asm volatile("s_waitcnt vmcnt(" #n ")" ::: "memory")
#define PG8_WAIT_L(n) asm volatile("s_waitcnt lgkmcnt(" #n ")" ::: "memory")
#define PG8_BAR __builtin_amdgcn_s_barrier()
#define PG8_SCHED __builtin_amdgcn_sched_barrier(0)
    Unit cur, nxt; int ui = 0;
    if (!S.next(0, cur)) return;
    f32x4 acc[2][2][4][2];
#pragma unroll
    for (int a = 0; a < 2; ++a)
#pragma unroll
        for (int b = 0; b < 2; ++b)
#pragma unroll
            for (int m = 0; m < 4; ++m)
#pragma unroll
                for (int n = 0; n < 2; ++n) acc[a][b][m][n] = (f32x4){0.f, 0.f, 0.f, 0.f};
    bf16x8 At[4][2], B0[2][2], B1[2][2];
    const char* cA = (const char*)g.A + (size_t)cur.pm * tstepA; const char* cB = (const char*)g.Bt + (size_t)cur.pn * tstepB;
    PG8_STAGE(PG8_SB(0, 0), cB, voffB); PG8_STAGE(PG8_SB(0, 1), cB + hstepB, voffB); PG8_STAGE(PG8_SA(0, 0), cA, voffA); PG8_STAGE(PG8_SA(0, 1), cA + hstepA, voffA);
    if (wr == 1) PG8_BAR;
    PG8_WAIT_V(2); PG8_BAR;
    PG8_STAGE(PG8_SB(1, 0), cB + kstep, voffB); PG8_STAGE(PG8_SA(1, 0), cA + kstep, voffA); PG8_STAGE(PG8_SB(1, 1), cB + hstepB + kstep, voffB);
    PG8_WAIT_V(6); PG8_BAR;
    for (;;) {
        const bool has_next = S.next(ui + 1, nxt);
        const char* nA = has_next ? (const char*)g.A + (size_t)nxt.pm * tstepA : cA; const char* nB = has_next ? (const char*)g.Bt + (size_t)nxt.pn * tstepB : cB;
        for (int t = 0; t < nt; t += 2) {
            const bool last = (t == nt - 2);
            const char* a1 = cA + (size_t)(t + 1) * kstep;
            const char* a2 = last ? nA : cA + (size_t)(t + 2) * kstep; const char* b2 = last ? nB : cB + (size_t)(t + 2) * kstep;
            const char* a3 = a2 + kstep; const char* b3 = b2 + kstep;
            PG8_LDB(B0, 0, 0); PG8_LDB(B1, 0, 1); PG8_SCHED; PG8_LDA(At, 0, 0); PG8_STAGE(PG8_SA(1, 1), a1 + hstepA, voffA);
            PG8_WAIT_V(8); PG8_WAIT_L(0); PG8_BAR; PG8_MMA(0, 0, At, B0); PG8_MMA(0, 1, At, B1); PG8_BAR; PG8_SCHED;
            PG8_LDA(At, 0, 1); PG8_STAGE(PG8_SB(0, 0), b2, voffB); PG8_STAGE(PG8_SB(0, 1), b2 + hstepB, voffB); PG8_STAGE(PG8_SA(0, 0), a2, voffA);
            PG8_WAIT_V(8); PG8_WAIT_L(0); PG8_BAR; PG8_MMA(1, 0, At, B0); PG8_MMA(1, 1, At, B1); PG8_BAR; PG8_SCHED;
            PG8_LDB(B0, 1, 0); PG8_LDB(B1, 1, 1); PG8_SCHED; PG8_LDA(At, 1, 0); PG8_STAGE(PG8_SA(0, 1), a2 + hstepA, voffA);
            PG8_WAIT_V(8); PG8_WAIT_L(0); PG8_BAR; PG8_MMA(0, 0, At, B0); PG8_MMA(0, 1, At, B1); PG8_BAR; PG8_SCHED;
            PG8_LDA(At, 1, 1); PG8_STAGE(PG8_SB(1, 0), b3, voffB); PG8_STAGE(PG8_SB(1, 1), b3 + hstepB, voffB); PG8_STAGE(PG8_SA(1, 0), a3, voffA);
            PG8_WAIT_V(8); PG8_WAIT_L(0); PG8_BAR; PG8_MMA(1, 0, At, B0); PG8_MMA(1, 1, At, B1); PG8_BAR; PG8_SCHED;
        }
        if constexpr (ALIGN_EPI) { if (wr == 0) PG8_BAR; }
        E(acc, cur, wr, wc, fr, fq);
        H(cur, wid);
        if (!has_next) break;
#pragma unroll
        for (int a = 0; a < 2; ++a)
#pragma unroll
            for (int b = 0; b < 2; ++b)
#pragma unroll
                for (int m = 0; m < 4; ++m)
#pragma unroll
                    for (int n = 0; n < 2; ++n) acc[a][b][m][n] = (f32x4){0.f, 0.f, 0.f, 0.f};
        cur = nxt; cA = nA; cB = nB; ++ui;
        if constexpr (ALIGN_EPI) { if (wr == 1) PG8_BAR; }
    }
    PG8_WAIT_V(0);
    if constexpr (!ALIGN_EPI) { if (wr == 0) PG8_BAR; }
    PG8_BAR;
#undef PG8_SA
#undef PG8_SB
#undef PG8_STAGE
#undef PG8_LDA
#undef PG8_LDB
#undef PG8_MMA
#undef PG8_WAIT_V
#undef PG8_WAIT_L
#undef PG8_BAR
#undef PG8_SCHED
}
}

typedef f32x4 AccT[2][2][4][2];
#define EPI_LOOP_BEGIN \
    _Pragma("unroll") for (int ai = 0; ai < 2; ++ai) _Pragma("unroll") for (int m = 0; m < 4; ++m) { const int row = u.pm * 256 + ai * 128 + wr * 64 + m * 16 + fr; \
    _Pragma("unroll") for (int bj = 0; bj < 2; ++bj) { const int col = u.pn * 256 + bj * 128 + wc * 32 + 8 * fq; const f32x4 v0 = acc[ai][bj][m][0], v1 = acc[ai][bj][m][1];
#define EPI_LOOP_END } asm volatile("" ::: "memory"); }

struct EpiIn {
    bf16_t* Z; float* gates; const float* bg;
    __device__ __forceinline__ void operator()(const AccT& acc, const pg8::Unit& u, int wr, int wc, int fr, int fq) const {
        { const int l_ = fresh_lane(); fr = l_ & 15; fq = l_ >> 4; }
        EPI_LOOP_BEGIN
            u32x4 w; w.x = cvtpk(v0[0], v0[1]); w.y = cvtpk(v0[2], v0[3]); w.z = cvtpk(v1[0], v1[1]); w.w = cvtpk(v1[2], v1[3]);
            *(u32x4*)(Z + (size_t)row * DINP + col) = w;
            if (col == ZI) {
                const f32x4 b0 = *(const f32x4*)(bg), b1 = *(const f32x4*)(bg + 4);
                *(f32x4*)(gates + (size_t)row * 8) = v0 + b0; *(f32x4*)(gates + (size_t)row * 8 + 4) = v1 + b1;
            }
        EPI_LOOP_END
    }
};
struct EpiQ {
    bf16_t* Q;
    __device__ __forceinline__ void operator()(const AccT& acc, const pg8::Unit& u, int wr, int wc, int fr, int fq) const {
        { const int l_ = fresh_lane(); fr = l_ & 15; fq = l_ >> 4; }
        const int row0 = u.pm * 256 + wr * 64 + fr; const int b = row0 >> 12, s0 = row0 & 4095;
#pragma unroll
        for (int bj = 0; bj < 2; ++bj) {
            const int col = u.pn * 256 + bj * 128 + wc * 32 + 8 * fq; const int head = col / 96, w = col - head * 96;
            bf16_t* pb = Q + ((size_t)((b * NH + head) * SEQ + s0)) * DQK + w;
#pragma unroll
            for (int ai = 0; ai < 2; ++ai)
#pragma unroll
                for (int m = 0; m < 4; ++m) {
                    const f32x4 v0 = acc[ai][bj][m][0], v1 = acc[ai][bj][m][1];
                    u32x4 o; o.x = cvtpk(v0[0], v0[1]); o.y = cvtpk(v0[2], v0[3]); o.z = cvtpk(v1[0], v1[1]); o.w = cvtpk(v1[2], v1[3]);
                    *(u32x4*)(pb + (ai * 128 + m * 16) * DQK) = o;
                }
            asm volatile("" ::: "memory");
        }
    }
};
struct EpiKV {
    bf16_t* Kn; bf16_t* Vt; const float* rstd;
    __device__ __forceinline__ void operator()(const AccT& acc, const pg8::Unit& u, int wr, int wc, int fr, int fq) const {
        { const int l_ = fresh_lane(); fr = l_ & 15; fq = l_ >> 4; }
        const int row0 = u.pm * 256 + wr * 64 + fr; const int b = row0 >> 12, s0 = row0 & 4095;
        const int w = wc * 32 + 8 * fq;
        const int posfr = (((fr >> 2) & 1) << 3) | (((fr >> 3) & 1) << 2) | (fr & 3);
#pragma unroll
        for (int bj = 0; bj < 2; ++bj) {
            const int head = u.pn * 2 + bj;
            bf16_t* pk = Kn + ((size_t)((b * NH + head) * SEQ + s0)) * DNOPE + w;
            bf16_t* pv = Vt + ((size_t)((b * NH + head) * (SEQ / 32) + (s0 >> 5))) * (DV * 32) + (w - 64) * 32 + posfr;
#pragma unroll
            for (int ai = 0; ai < 2; ++ai)
#pragma unroll
                for (int m = 0; m < 4; ++m) {
                    const float sc = rstd[row0 + ai * 128 + m * 16];
                    const f32x4 a0 = acc[ai][bj][m][0] * sc, a1 = acc[ai][bj][m][1] * sc;
                    if (wc < 2) {
                        u32x4 o; o.x = cvtpk(a0[0], a0[1]); o.y = cvtpk(a0[2], a0[3]); o.z = cvtpk(a1[0], a1[1]); o.w = cvtpk(a1[2], a1[3]);
                        *(u32x4*)(pk + (ai * 128 + m * 16) * DNOPE) = o;
                    } else {
                        bf16_t* p = pv + (ai * 4 + (m >> 1)) * (DV * 32) + 16 * (m & 1);
                        p[0 * 32] = f2bf(a0[0]); p[1 * 32] = f2bf(a0[1]); p[2 * 32] = f2bf(a0[2]); p[3 * 32] = f2bf(a0[3]);
                        p[4 * 32] = f2bf(a1[0]); p[5 * 32] = f2bf(a1[1]); p[6 * 32] = f2bf(a1[2]); p[7 * 32] = f2bf(a1[3]);
                    }
                    asm volatile("" ::: "memory");
                }
        }
    }
};
struct EpiRes {
    const float* base; float* out; const float* gate;
    __device__ __forceinline__ void operator()(const AccT& acc, const pg8::Unit& u, int wr, int wc, int fr, int fq) const {
        { const int l_ = fresh_lane(); fr = l_ & 15; fq = l_ >> 4; }
        const int row0 = u.pm * 256 + wr * 64 + fr; const int b = row0 >> 12;
        const int col0 = u.pn * 256 + wc * 32 + 8 * fq;
        f32x4 g[2][2];
#pragma unroll
        for (int bj = 0; bj < 2; ++bj) { g[bj][0] = *(const f32x4*)(gate + b * 6144 + col0 + bj * 128); g[bj][1] = *(const f32x4*)(gate + b * 6144 + col0 + bj * 128 + 4); }
#pragma unroll
        for (int ai = 0; ai < 2; ++ai) {
            f32x4 xv[4][2][2];
#pragma unroll
            for (int m = 0; m < 4; ++m)
#pragma unroll
                for (int bj = 0; bj < 2; ++bj) { const size_t off = (size_t)(row0 + ai * 128 + m * 16) * DM + col0 + bj * 128; xv[m][bj][0] = __builtin_nontemporal_load((const f32x4*)(base + off)); xv[m][bj][1] = __builtin_nontemporal_load((const f32x4*)(base + off + 4)); }
#pragma unroll
            for (int m = 0; m < 4; ++m)
#pragma unroll
                for (int bj = 0; bj < 2; ++bj) { const size_t off = (size_t)(row0 + ai * 128 + m * 16) * DM + col0 + bj * 128;
                    *(f32x4*)(out + off) = xv[m][bj][0] + g[bj][0] * acc[ai][bj][m][0]; *(f32x4*)(out + off + 4) = xv[m][bj][1] + g[bj][1] * acc[ai][bj][m][1]; }
            asm volatile("" ::: "memory");
        }
    }
};
struct EpiResNorm {
    const float* base; float* out; const float* gate; const float* gfin;
    float* xbuf;
    unsigned* cnt;
    LAS unsigned char* l;
    __device__ __forceinline__ void operator()(AccT& acc, const pg8::Unit& u, int wr, int wc, int fr, int fq) const {
        const int lane = fresh_lane(); fr = lane & 15; fq = lane >> 4;
        const int wid = wr * 4 + wc;
        const int row0 = u.pm * 256 + wr * 64 + fr; const int b = row0 >> 12;
        const int col0 = u.pn * 256 + wc * 32 + 8 * fq;
        LAS float* P = (LAS float*)l; LAS float* S = (LAS float*)(l + 4096); volatile LAS unsigned* flag = (volatile LAS unsigned*)(l + 4096 + 1024);
        float sp[2][4];
        {
            f32x4 g[2][2];
#pragma unroll
            for (int bj = 0; bj < 2; ++bj) { g[bj][0] = *(const f32x4*)(gate + b * 6144 + col0 + bj * 128); g[bj][1] = *(const f32x4*)(gate + b * 6144 + col0 + bj * 128 + 4); }
#pragma unroll
            for (int am = 0; am < 4; ++am) {
                const int ai = am >> 1, mb = (am & 1) * 2;
                f32x4 xv[2][2][2];
#pragma unroll
                for (int m2 = 0; m2 < 2; ++m2)
#pragma unroll
                    for (int bj = 0; bj < 2; ++bj) { const size_t off = (size_t)(row0 + ai * 128 + (mb + m2) * 16) * DM + col0 + bj * 128; xv[m2][bj][0] = *(const f32x4*)(base + off); xv[m2][bj][1] = *(const f32x4*)(base + off + 4); }
#pragma unroll
                for (int m2 = 0; m2 < 2; ++m2) {
                    const int m = mb + m2;
                    float q = 0.f;
#pragma unroll
                    for (int bj = 0; bj < 2; ++bj) {
                        const f32x4 r0 = xv[m2][bj][0] + g[bj][0] * acc[ai][bj][m][0], r1 = xv[m2][bj][1] + g[bj][1] * acc[ai][bj][m][1];
                        acc[ai][bj][m][0] = r0; acc[ai][bj][m][1] = r1;
                        q += (r0[0] * r0[0] + r0[1] * r0[1]) + (r0[2] * r0[2] + r0[3] * r0[3]) + (r1[0] * r1[0] + r1[1] * r1[1]) + (r1[2] * r1[2] + r1[3] * r1[3]);
                    }
                    q += __shfl_xor(q, 16); q += __shfl_xor(q, 32);
                    sp[ai][m] = q;
                }
                asm volatile("" ::: "memory");
            }
        }
        if (fq == 0) {
#pragma unroll
            for (int ai = 0; ai < 2; ++ai)
#pragma unroll
                for (int m = 0; m < 4; ++m) P[(ai * 128 + wr * 64 + m * 16 + fr) * 4 + wc] = sp[ai][m];
        }
        asm volatile("s_waitcnt lgkmcnt(0)" ::: "memory"); __builtin_amdgcn_s_barrier(); asm volatile("" ::: "memory");
        const int prow = wid * 32 + (lane & 31);
        if (lane < 32) {
            const float t = (P[prow * 4 + 0] + P[prow * 4 + 1]) + (P[prow * 4 + 2] + P[prow * 4 + 3]);
            __hip_atomic_store((unsigned*)xbuf + (size_t)(u.pm * 256 + prow) * 4 + u.pn, __float_as_uint(t), __ATOMIC_RELAXED, __HIP_MEMORY_SCOPE_AGENT);
        }
        asm volatile("s_waitcnt vmcnt(0)" ::: "memory");
        if (lane == 0) __hip_atomic_fetch_add(cnt + u.pm, 1u, __ATOMIC_RELAXED, __HIP_MEMORY_SCOPE_AGENT);
        if (wid == 0) {
            unsigned spins = 0;
            while ((unsigned)__builtin_amdgcn_readfirstlane(__hip_atomic_load(cnt + u.pm, __ATOMIC_RELAXED, __HIP_MEMORY_SCOPE_AGENT)) < 32u) { __builtin_amdgcn_s_sleep(2); if (++spins > (1u << 22)) break; }
            __builtin_amdgcn_fence(__ATOMIC_ACQUIRE, "agent");
            if (lane == 0) flag[0] = 1u;
        }
        asm volatile("s_waitcnt vmcnt(0) lgkmcnt(0)" ::: "memory"); __builtin_amdgcn_s_barrier(); asm volatile("" ::: "memory");
        if (lane < 32) {
            const unsigned* slot = (const unsigned*)xbuf + (size_t)(u.pm * 256 + prow) * 4;
            float t = 0.f;
#pragma unroll
            for (int k = 0; k < 4; ++k) t += __uint_as_float(__hip_atomic_load(slot + k, __ATOMIC_RELAXED, __HIP_MEMORY_SCOPE_AGENT));
            S[prow] = rsqrtf(t * (1.f / DM) + EPS);
        }
        asm volatile("s_waitcnt lgkmcnt(0)" ::: "memory"); __builtin_amdgcn_s_barrier(); asm volatile("" ::: "memory");
        f32x4 gf[2][2];
#pragma unroll
        for (int bj = 0; bj < 2; ++bj) { gf[bj][0] = *(const f32x4*)(gfin + col0 + bj * 128); gf[bj][1] = *(const f32x4*)(gfin + col0 + bj * 128 + 4); }
#pragma unroll
        for (int ai = 0; ai < 2; ++ai)
#pragma unroll
            for (int m = 0; m < 4; ++m) {
                const float rs = S[ai * 128 + wr * 64 + m * 16 + fr];
#pragma unroll
                for (int bj = 0; bj < 2; ++bj) { const size_t off = (size_t)(row0 + ai * 128 + m * 16) * DM + col0 + bj * 128;
                    *(f32x4*)(out + off) = acc[ai][bj][m][0] * rs * gf[bj][0]; *(f32x4*)(out + off + 4) = acc[ai][bj][m][1] * rs * gf[bj][1]; }
            }
        asm volatile("s_waitcnt lgkmcnt(0)" ::: "memory");
    }
};
struct EpiGU {
    static constexpr bool PREFETCH = false;
    bf16_t* act;
    __device__ __forceinline__ void operator()(const AccT& acc, const pg8::Unit& u, int wr, int wc, int fr, int fq) const {
        { const int l_ = fresh_lane(); fr = l_ & 15; fq = l_ >> 4; }
        const int odd = fq & 1;
        const int row0 = u.pm * 256 + wr * 64 + fr + 16 * odd;
        const int acol0 = u.pn * 128 + wc * 16 + 4 * (fq & ~1);
#pragma unroll
        for (int ai = 0; ai < 2; ++ai)
#pragma unroll
            for (int mp = 0; mp < 2; ++mp) {
#pragma unroll
                for (int bj = 0; bj < 2; ++bj) {
                    const f32x4 g0 = acc[ai][bj][2 * mp][0], u0 = acc[ai][bj][2 * mp][1], g1 = acc[ai][bj][2 * mp + 1][0], u1 = acc[ai][bj][2 * mp + 1][1];
                    unsigned ax = cvtpk(siluf(g0[0]) * u0[0], siluf(g0[1]) * u0[1]), ay = cvtpk(siluf(g0[2]) * u0[2], siluf(g0[3]) * u0[3]);
                    unsigned bx = cvtpk(siluf(g1[0]) * u1[0], siluf(g1[1]) * u1[1]), by = cvtpk(siluf(g1[2]) * u1[2], siluf(g1[3]) * u1[3]);
                    { auto r = __builtin_amdgcn_permlane16_swap(ax, bx, false, false); ax = r[0]; bx = r[1]; }
                    { auto r = __builtin_amdgcn_permlane16_swap(ay, by, false, false); ay = r[0]; by = r[1]; }
                    u32x4 o; o.x = ax; o.y = ay; o.z = bx; o.w = by;
                    *(u32x4*)(act + (size_t)(row0 + ai * 128 + mp * 32) * DFF + acol0 + bj * 64) = o;
                }
                asm volatile("" ::: "memory");
            }
    }
};

__device__ __forceinline__ int map_row(int mapid, int n) {
    if (mapid == 1) { const int head = n / 96, w = n - head * 96; if (w < 64) return n; const int r = w - 64; const int p = (r < 16) ? 2 * r : 2 * (r - 16) + 1; return head * 96 + 64 + p; }
    if (mapid == 2) return 8 * (n >> 2) + (n & 3);
    if (mapid == 3) return 8 * (n >> 2) + 4 + (n & 3);
    return n;
}
__device__ __forceinline__ void transpose_item(const float* W, int K, int N, int Npad, bf16_t* WT, int mapid, const float* kscale, LAS float* scr, int item, int lane) {
    const int nblk = Npad / 32, kb = item / nblk, nb = item % nblk, k0 = 64 * kb, n0 = 32 * nb;
    const int nn = n0 + (lane & 31);
#pragma unroll
    for (int i = 0; i < 32; ++i) { const int kk = 2 * i + (lane >> 5); float v = 0.f; if (nn < N) { v = __builtin_nontemporal_load(W + (size_t)(k0 + kk) * N + nn); if (kscale) v *= kscale[k0 + kk]; } scr[kk * 33 + (lane & 31)] = v; }
    asm volatile("s_waitcnt lgkmcnt(0)" ::: "memory");
    const int c = lane & 7;
#pragma unroll
    for (int j = 0; j < 4; ++j) { const int n = (lane >> 3) + 8 * j; const LAS float* s = scr + (8 * c) * 33 + n;
        u32x4 o; o.x = cvtpk(s[0 * 33], s[1 * 33]); o.y = cvtpk(s[2 * 33], s[3 * 33]); o.z = cvtpk(s[4 * 33], s[5 * 33]); o.w = cvtpk(s[6 * 33], s[7 * 33]);
        const int nsrc = n0 + n; const int drow = (nsrc < N) ? map_row(mapid, nsrc) : nsrc;
        *(u32x4*)(WT + (size_t)drow * K + k0 + 8 * c) = o; }
    asm volatile("s_waitcnt lgkmcnt(0)" ::: "memory");
}

constexpr int AT_KROW = 208, AT_VROW = 144, AT_KBYTES = 64 * AT_KROW, AT_BUF = AT_KBYTES + 64 * AT_VROW;
__device__ __forceinline__ void attn_unit(LAS unsigned char* lds, const bf16_t* __restrict__ Q, const bf16_t* __restrict__ Kn, const bf16_t* __restrict__ Kr, const bf16_t* __restrict__ Vt,
                                          bf16_t* Y, const float* __restrict__ gout, const float* __restrict__ rstdq, const float* __restrict__ cosT, const float* __restrict__ sinT,
                                          int b, int hd, int qb, int wave, int lane) {
    asm volatile("" : "+v"(lane)); lane &= 63;
    const int r32 = lane & 31, hi = lane >> 5, tid = wave * 64 + lane;
    const int qrow0 = qb * 512 + wave * 64;
    bf16x8 qf[2][6];
#pragma unroll
    for (int i = 0; i < 2; ++i) {
        const int q = qrow0 + 32 * i + r32;
        const bf16_t* Qp = Q + ((size_t)((b * NH + hd) * SEQ + q)) * DQK + 8 * hi;
        const float qsc = rstdq[(size_t)b * SEQ + q] * QSCALE;
#pragma unroll
        for (int d0 = 0; d0 < 6; ++d0) {
            const u32x4 qu = *(const u32x4*)(Qp + 16 * d0);
            float e0 = bflo(qu.x) * qsc, e1 = bfhi(qu.x) * qsc, e2 = bflo(qu.y) * qsc, e3 = bfhi(qu.y) * qsc, e4 = bflo(qu.z) * qsc, e5 = bfhi(qu.z) * qsc, e6 = bflo(qu.w) * qsc, e7 = bfhi(qu.w) * qsc;
            if (d0 >= 4) {
                const int i0 = 8 * (d0 - 4) + 4 * hi;
                const f32x4 c = *(const f32x4*)(cosT + ((size_t)b * SEQ + q) * 16 + i0), sn = *(const f32x4*)(sinT + ((size_t)b * SEQ + q) * 16 + i0);
                const float t0 = e0 * c[0] - e1 * sn[0], t1 = e1 * c[0] + e0 * sn[0], t2 = e2 * c[1] - e3 * sn[1], t3 = e3 * c[1] + e2 * sn[1];
                const float t4 = e4 * c[2] - e5 * sn[2], t5 = e5 * c[2] + e4 * sn[2], t6 = e6 * c[3] - e7 * sn[3], t7 = e7 * c[3] + e6 * sn[3];
                e0 = t0; e1 = t1; e2 = t2; e3 = t3; e4 = t4; e5 = t5; e6 = t6; e7 = t7;
            }
            u32x4 o; o.x = cvtpk(e0, e1); o.y = cvtpk(e2, e3); o.z = cvtpk(e4, e5); o.w = cvtpk(e6, e7);
            qf[i][d0] = __builtin_bit_cast(bf16x8, o);
        }
    }
    const int NTL = 8 * (qb + 1), tmax = qrow0 >> 6;
    const bf16_t* gK = Kn + ((size_t)((b * NH + hd) * SEQ + (tid >> 3))) * DNOPE + (tid & 7) * 8;
    const bf16_t* gKr = Kr + ((size_t)(b * SEQ + (tid >> 2))) * DROPE + (tid & 3) * 8;
    const bf16_t* gV = Vt + (((size_t)(b * NH + hd) * (SEQ / 32) + (tid >> 8)) * DV + ((tid >> 2) & 63)) * 32 + (tid & 3) * 8;
    const unsigned lK = (tid >> 3) * AT_KROW + (tid & 7) * 16, lKr = (tid >> 2) * AT_KROW + 128 + (tid & 3) * 16;
    const unsigned lV = AT_KBYTES + ((tid >> 2) & 63) * AT_VROW + (tid >> 8) * 64 + (tid & 3) * 16;
    u32x4 sk, skr = {0u, 0u, 0u, 0u}, sv;
    sk = *(const u32x4*)gK; if (tid < 256) skr = *(const u32x4*)gKr; sv = *(const u32x4*)gV;
    *(LAS u32x4*)(lds + lK) = sk; if (tid < 256) *(LAS u32x4*)(lds + lKr) = skr; *(LAS u32x4*)(lds + lV) = sv;
    __syncthreads();
    f32x16 o[2][2];
#pragma unroll
    for (int i = 0; i < 2; ++i)
#pragma unroll
        for (int r = 0; r < 16; ++r) { o[i][0][r] = 0.f; o[i][1][r] = 0.f; }
    constexpr float ATT_THR = 8.f;
    float mref[2] = {0.f, 0.f}, lrun[2] = {0.f, 0.f};
#pragma unroll 1
    for (int t = 0; t < NTL; ++t) {
        const unsigned cur = (t & 1) * AT_BUF, nxt = AT_BUF - cur;
        if (t + 1 < NTL) {
            sk = *(const u32x4*)(gK + (size_t)(t + 1) * 64 * DNOPE); if (tid < 256) skr = *(const u32x4*)(gKr + (size_t)(t + 1) * 64 * DROPE);
            sv = *(const u32x4*)(gV + (size_t)(t + 1) * 2 * DV * 32);
        }
        if (t <= tmax) {
            const LAS unsigned char* kb = lds + cur + r32 * AT_KROW + hi * 16;
            f32x16 s[2][2];
#pragma unroll
            for (int i = 0; i < 2; ++i)
#pragma unroll
                for (int r = 0; r < 16; ++r) { s[i][0][r] = 0.f; s[i][1][r] = 0.f; }
#pragma unroll
            for (int d0 = 0; d0 < 6; ++d0) {
                const bf16x8 k0 = *(const LAS bf16x8*)(kb + d0 * 32), k1 = *(const LAS bf16x8*)(kb + 32 * AT_KROW + d0 * 32);
                s[0][0] = __builtin_amdgcn_mfma_f32_32x32x16_bf16(k0, qf[0][d0], s[0][0], 0, 0, 0);
                s[0][1] = __builtin_amdgcn_mfma_f32_32x32x16_bf16(k1, qf[0][d0], s[0][1], 0, 0, 0);
                s[1][0] = __builtin_amdgcn_mfma_f32_32x32x16_bf16(k0, qf[1][d0], s[1][0], 0, 0, 0);
                s[1][1] = __builtin_amdgcn_mfma_f32_32x32x16_bf16(k1, qf[1][d0], s[1][1], 0, 0, 0);
            }
            u32x4 p[2][4];
#pragma unroll
            for (int i = 0; i < 2; ++i) {
                f32x16 s0 = s[i][0] - mref[i], s1 = s[i][1] - mref[i];
                if (t == tmax) {
                    const int qrel = 32 * i + r32;
#pragma unroll
                    for (int r = 0; r < 16; ++r) { const int key = crow(r, hi); if (key > qrel) s0[r] = -INFINITY; if (key + 32 > qrel) s1[r] = -INFINITY; }
                }
                float mx = fmaxf(fmaxf(s0[0], s1[0]), fmaxf(s0[1], s1[1]));
#pragma unroll
                for (int r = 2; r < 16; r += 2) mx = fmaxf(fmaxf(mx, fmaxf(s0[r], s1[r])), fmaxf(s0[r + 1], s1[r + 1]));
                mx = fmaxf(mx, __shfl_xor(mx, 32));
                if (t == 0 || __any(mx > ATT_THR)) {
                    const float dl = (t == 0) ? mx : fmaxf(mx, 0.f);
                    mref[i] += dl;
                    s0 = s0 - dl; s1 = s1 - dl;
                    const float alpha = __builtin_amdgcn_exp2f(-dl);
                    lrun[i] *= alpha; o[i][0] = o[i][0] * alpha; o[i][1] = o[i][1] * alpha;
                }
#pragma unroll
                for (int r = 0; r < 16; ++r) { s0[r] = __builtin_amdgcn_exp2f(s0[r]); s1[r] = __builtin_amdgcn_exp2f(s1[r]); }
                {
                    const f32x16 ts = s0 + s1;
                    lrun[i] += ((ts[0] + ts[1]) + (ts[2] + ts[3])) + ((ts[4] + ts[5]) + (ts[6] + ts[7])) + ((ts[8] + ts[9]) + (ts[10] + ts[11])) + ((ts[12] + ts[13]) + (ts[14] + ts[15]));
                }
                p[i][0].x = cvtpk(s0[0], s0[1]); p[i][0].y = cvtpk(s0[2], s0[3]); p[i][0].z = cvtpk(s0[4], s0[5]); p[i][0].w = cvtpk(s0[6], s0[7]);
                p[i][1].x = cvtpk(s0[8], s0[9]); p[i][1].y = cvtpk(s0[10], s0[11]); p[i][1].z = cvtpk(s0[12], s0[13]); p[i][1].w = cvtpk(s0[14], s0[15]);
                p[i][2].x = cvtpk(s1[0], s1[1]); p[i][2].y = cvtpk(s1[2], s1[3]); p[i][2].z = cvtpk(s1[4], s1[5]); p[i][2].w = cvtpk(s1[6], s1[7]);
                p[i][3].x = cvtpk(s1[8], s1[9]); p[i][3].y = cvtpk(s1[10], s1[11]); p[i][3].z = cvtpk(s1[12], s1[13]); p[i][3].w = cvtpk(s1[14], s1[15]);
            }
            const LAS unsigned char* vb = lds + cur + AT_KBYTES + r32 * AT_VROW + hi * 16;
#pragma unroll
            for (int kk = 0; kk < 4; ++kk) {
                const bf16x8 v0 = *(const LAS bf16x8*)(vb + kk * 32), v1 = *(const LAS bf16x8*)(vb + 32 * AT_VROW + kk * 32);
                const bf16x8 pf0 = __builtin_bit_cast(bf16x8, p[0][kk]), pf1 = __builtin_bit_cast(bf16x8, p[1][kk]);
                o[0][0] = __builtin_amdgcn_mfma_f32_32x32x16_bf16(v0, pf0, o[0][0], 0, 0, 0);
                o[0][1] = __builtin_amdgcn_mfma_f32_32x32x16_bf16(v1, pf0, o[0][1], 0, 0, 0);
                o[1][0] = __builtin_amdgcn_mfma_f32_32x32x16_bf16(v0, pf1, o[1][0], 0, 0, 0);
                o[1][1] = __builtin_amdgcn_mfma_f32_32x32x16_bf16(v1, pf1, o[1][1], 0, 0, 0);
            }
        }
        if (t + 1 < NTL) { *(LAS u32x4*)(lds + nxt + lK) = sk; if (tid < 256) *(LAS u32x4*)(lds + nxt + lKr) = skr; *(LAS u32x4*)(lds + nxt + lV) = sv; }
        __syncthreads();
    }
#pragma unroll
    for (int i = 0; i < 2; ++i) {
        const int q = qrow0 + 32 * i + r32;
        const float ltot = lrun[i] + __shfl_xor(lrun[i], 32);
        const float inv = 1.f / ltot;
        float ssq = 0.f;
#pragma unroll
        for (int r = 0; r < 16; ++r) { o[i][0][r] *= inv; o[i][1][r] *= inv; ssq += o[i][0][r] * o[i][0][r] + o[i][1][r] * o[i][1][r]; }
        ssq += __shfl_xor(ssq, 32);
        const float rs = rsqrtf(ssq * (1.f / DV) + EPS);
        bf16_t* yp = Y + (size_t)(b * SEQ + q) * DMIX + hd * DV + 4 * hi;
        const float* gp = gout + hd * DV + 4 * hi;
#pragma unroll
        for (int g = 0; g < 4; ++g) {
            const f32x4 g0 = *(const f32x4*)(gp + 8 * g), g1 = *(const f32x4*)(gp + 32 + 8 * g);
            u32x2 w0, w1;
            w0.x = cvtpk(o[i][0][4 * g] * rs * g0[0], o[i][0][4 * g + 1] * rs * g0[1]); w0.y = cvtpk(o[i][0][4 * g + 2] * rs * g0[2], o[i][0][4 * g + 3] * rs * g0[3]);
            w1.x = cvtpk(o[i][1][4 * g] * rs * g1[0], o[i][1][4 * g + 1] * rs * g1[1]); w1.y = cvtpk(o[i][1][4 * g + 2] * rs * g1[2], o[i][1][4 * g + 3] * rs * g1[3]);
            *(u32x2*)(yp + 8 * g) = w0; *(u32x2*)(yp + 32 + 8 * g) = w1;
        }
    }
}

__device__ __forceinline__ float wave_incl_scan(float v, int lane) {
#pragma unroll
    for (int o = 1; o < 64; o <<= 1) { const float t = __shfl_up(v, o); if (lane >= o) v += t; }
    return v;
}
__device__ __forceinline__ void mlstm_chunk_state(int ch, const bf16_t* __restrict__ Z, const bf16_t* __restrict__ Km, const float* __restrict__ gates,
                                                  float* dC, float* dn, float* mloc, float* btot, int lane) {
    asm volatile("" : "+v"(lane)); lane &= 63;
    const int c = ch & 63, hh = (ch >> 6) & 3, b = ch >> 8;
    const int r32 = lane & 31, hi = lane >> 5;
    const size_t row0 = (size_t)b * SEQ + c * CHUNK;
    const float gi = gates[(row0 + lane) * 8 + hh], gf = gates[(row0 + lane) * 8 + 4 + hh];
    const float lf = logsigmoidf_(gf);
    const float bcum = wave_incl_scan(lf, lane);
    const float bt = __shfl(bcum, 63);
    const float g = bt - bcum + gi;
    const float ml = wave_max(g);
    const float wgt = __expf(g - ml);
    f32x16 acc[4][2];
#pragma unroll
    for (int vb = 0; vb < 4; ++vb)
#pragma unroll
        for (int kb = 0; kb < 2; ++kb)
#pragma unroll
            for (int r = 0; r < 16; ++r) acc[vb][kb][r] = 0.f;
    float dnp[2] = {0.f, 0.f};
    const bf16_t* Vp = Z + row0 * DINP + ZV + hh * MDV + r32;
    const bf16_t* Kp = Km + ((size_t)((b * MH + hh) * SEQ + c * CHUNK)) * MDK + r32;
#pragma unroll 2
    for (int ks = 0; ks < 4; ++ks) {
        const int l0 = 16 * ks + 8 * hi;
        float w[8];
#pragma unroll
        for (int j = 0; j < 8; ++j) w[j] = __shfl(wgt, l0 + j);
        bf16x8 bfr[2];
#pragma unroll
        for (int kb = 0; kb < 2; ++kb) {
            float kv[8];
#pragma unroll
            for (int j = 0; j < 8; ++j) { kv[j] = bf2f(Kp[(size_t)(l0 + j) * MDK + 32 * kb]) * w[j]; dnp[kb] += kv[j]; }
            u32x4 p; p.x = cvtpk(kv[0], kv[1]); p.y = cvtpk(kv[2], kv[3]); p.z = cvtpk(kv[4], kv[5]); p.w = cvtpk(kv[6], kv[7]);
            bfr[kb] = __builtin_bit_cast(bf16x8, p);
        }
#pragma unroll
        for (int vb = 0; vb < 4; ++vb) {
            bf16x8 af;
#pragma unroll
            for (int j = 0; j < 8; ++j) af[j] = (short)Vp[(size_t)(l0 + j) * DINP + 32 * vb];
            acc[vb][0] = __builtin_amdgcn_mfma_f32_32x32x16_bf16(af, bfr[0], acc[vb][0], 0, 0, 0);
            acc[vb][1] = __builtin_amdgcn_mfma_f32_32x32x16_bf16(af, bfr[1], acc[vb][1], 0, 0, 0);
        }
    }
    float* dCp = dC + (size_t)ch * (MDV * MDK);
#pragma unroll
    for (int vb = 0; vb < 4; ++vb)
#pragma unroll
        for (int kb = 0; kb < 2; ++kb)
#pragma unroll
            for (int r = 0; r < 16; ++r) dCp[(32 * vb + crow(r, hi)) * MDK + 32 * kb + r32] = acc[vb][kb][r];
#pragma unroll
    for (int kb = 0; kb < 2; ++kb) { const float t = dnp[kb] + __shfl_xor(dnp[kb], 32); if (hi == 0) dn[(size_t)ch * MDK + 32 * kb + r32] = t; }
    if (lane == 0) { mloc[ch] = ml; btot[ch] = bt; }
}

__device__ __forceinline__ float wave_incl_scan_max(float v, int lane) {
#pragma unroll
    for (int o = 1; o < 64; o <<= 1) { const float t = __shfl_up(v, o); if (lane >= o) v = fmaxf(v, t); }
    return v;
}
__device__ __forceinline__ void mlstm_chunk_out(int ch, const bf16_t* __restrict__ Z, const bf16_t* __restrict__ Qm, const bf16_t* __restrict__ Km, const float* __restrict__ gates,
                                                const bf16_t* __restrict__ C0, const float* __restrict__ n0, const float* __restrict__ m0p, const float* __restrict__ gout,
                                                bf16_t* Y, int lane) {
    asm volatile("" : "+v"(lane)); lane &= 63;
    const int c = ch & 63, hh = (ch >> 6) & 3, b = ch >> 8;
    int r32 = lane & 31, hi = lane >> 5;
    const size_t row0 = (size_t)b * SEQ + c * CHUNK;
    const float gi = gates[(row0 + lane) * 8 + hh], gf = gates[(row0 + lane) * 8 + 4 + hh];
    const float lf = logsigmoidf_(gf);
    const float bcum = wave_incl_scan(lf, lane);
    const float uu = gi - bcum;
    const float pmax = wave_incl_scan_max(uu, lane);
    const float m0 = m0p[ch];
    const bf16_t* Qb = Qm + ((size_t)((b * MH + hh) * SEQ + c * CHUNK)) * MDK;
    const bf16_t* Kb = Km + ((size_t)((b * MH + hh) * SEQ + c * CHUNK)) * MDK;
    const bf16_t* Vp = Z + row0 * DINP + ZV + hh * MDV + r32;
    const bf16_t* C0p = C0 + (size_t)ch * (MDV * MDK);
    const float* n0p = n0 + (size_t)ch * MDK;
#pragma unroll 1
    for (int tb = 0; tb < 2; ++tb) {
        asm volatile("" : "+v"(r32), "+v"(hi)); r32 &= 31; hi &= 1;
        const int t = 32 * tb + r32;
        const float bt_t = __shfl(bcum, t), pm_t = __shfl(pmax, t);
        const float mt = bt_t + fmaxf(m0, pm_t);
        const float inter = __expf(bt_t + m0 - mt);
        const float dbase = bt_t - mt;
        bf16x8 qf[4];
#pragma unroll
        for (int d0 = 0; d0 < 4; ++d0) qf[d0] = *(const bf16x8*)(Qb + (size_t)t * MDK + 16 * d0 + 8 * hi);
        float dsum = 0.f;
        bf16x8 pf[2][2];
#pragma unroll
        for (int sb = 0; sb < 2; ++sb) {
            f32x16 sT;
#pragma unroll
            for (int r = 0; r < 16; ++r) sT[r] = 0.f;
            if (sb <= tb) {
#pragma unroll
                for (int d0 = 0; d0 < 4; ++d0) {
                    const bf16x8 kfr = *(const bf16x8*)(Kb + (size_t)(32 * sb + r32) * MDK + 16 * d0 + 8 * hi);
                    sT = __builtin_amdgcn_mfma_f32_32x32x16_bf16(kfr, qf[d0], sT, 0, 0, 0);
                }
            }
            float sc[16];
#pragma unroll
            for (int r = 0; r < 16; ++r) {
                const int s = 32 * sb + crow(r, hi);
                const float us = __shfl(uu, s);
                const float d = (s <= t) ? __expf(dbase + us) : 0.f;
                sc[r] = sT[r] * d; dsum += sc[r];
            }
            u32x4 p0, p1;
            p0.x = cvtpk(sc[0], sc[1]); p0.y = cvtpk(sc[2], sc[3]); p0.z = cvtpk(sc[4], sc[5]); p0.w = cvtpk(sc[6], sc[7]);
            p1.x = cvtpk(sc[8], sc[9]); p1.y = cvtpk(sc[10], sc[11]); p1.z = cvtpk(sc[12], sc[13]); p1.w = cvtpk(sc[14], sc[15]);
            pf[sb][0] = __builtin_bit_cast(bf16x8, p0); pf[sb][1] = __builtin_bit_cast(bf16x8, p1);
        }
        dsum += __shfl_xor(dsum, 32);
        float qn = 0.f; bf16x8 qs[4];
#pragma unroll
        for (int d0 = 0; d0 < 4; ++d0) {
            const f32x4 na = *(const f32x4*)(n0p + 16 * d0 + 8 * hi), nb = *(const f32x4*)(n0p + 16 * d0 + 8 * hi + 4);
            const u32x4 qu = __builtin_bit_cast(u32x4, qf[d0]);
            const float q0 = bflo(qu.x), q1 = bfhi(qu.x), q2 = bflo(qu.y), q3 = bfhi(qu.y), q4 = bflo(qu.z), q5 = bfhi(qu.z), q6 = bflo(qu.w), q7 = bfhi(qu.w);
            qn += q0 * na[0] + q1 * na[1] + q2 * na[2] + q3 * na[3] + q4 * nb[0] + q5 * nb[1] + q6 * nb[2] + q7 * nb[3];
            u32x4 o; o.x = cvtpk(q0 * inter, q1 * inter); o.y = cvtpk(q2 * inter, q3 * inter); o.z = cvtpk(q4 * inter, q5 * inter); o.w = cvtpk(q6 * inter, q7 * inter);
            qs[d0] = __builtin_bit_cast(bf16x8, o);
        }
        qn += __shfl_xor(qn, 32);
        const float den = dsum + inter * qn;
        const float rden = 1.f / fmaxf(fabsf(den), __expf(-mt));
        const bf16_t* zo = Z + (row0 + t) * DINP + ZO + hh * MDV + 4 * hi;
        f32x16 nm[4];
        float ssq = 0.f;
#pragma unroll
        for (int vb = 0; vb < 4; ++vb) {
#pragma unroll
            for (int r = 0; r < 16; ++r) nm[vb][r] = 0.f;
#pragma unroll
            for (int d0 = 0; d0 < 4; ++d0) {
                const bf16x8 cf = *(const bf16x8*)(C0p + (size_t)(32 * vb + r32) * MDK + 16 * d0 + 8 * hi);
                nm[vb] = __builtin_amdgcn_mfma_f32_32x32x16_bf16(cf, qs[d0], nm[vb], 0, 0, 0);
            }
#pragma unroll
            for (int sb = 0; sb < 2; ++sb) {
                if (sb <= tb) {
#pragma unroll
                    for (int ks = 0; ks < 2; ++ks) {
                        bf16x8 vf;
#pragma unroll
                        for (int j = 0; j < 8; ++j) { const int s = 32 * sb + 16 * ks + 8 * (j >> 2) + 4 * hi + (j & 3); vf[j] = (short)Vp[(size_t)s * DINP + 32 * vb]; }
                        nm[vb] = __builtin_amdgcn_mfma_f32_32x32x16_bf16(vf, pf[sb][ks], nm[vb], 0, 0, 0);
                    }
                }
            }
#pragma unroll
            for (int g = 0; g < 4; ++g) {
                const u32x2 ou = *(const u32x2*)(zo + 32 * vb + 8 * g);
                const float o0 = sigmoidf_(bflo(ou.x)), o1 = sigmoidf_(bfhi(ou.x)), o2 = sigmoidf_(bflo(ou.y)), o3 = sigmoidf_(bfhi(ou.y));
                nm[vb][4 * g] *= rden * o0; nm[vb][4 * g + 1] *= rden * o1; nm[vb][4 * g + 2] *= rden * o2; nm[vb][4 * g + 3] *= rden * o3;
                ssq += nm[vb][4 * g] * nm[vb][4 * g] + nm[vb][4 * g + 1] * nm[vb][4 * g + 1] + nm[vb][4 * g + 2] * nm[vb][4 * g + 2] + nm[vb][4 * g + 3] * nm[vb][4 * g + 3];
            }
            asm volatile("" ::: "memory");
        }
        ssq += __shfl_xor(ssq, 32);
        const float rs = rsqrtf(ssq * (1.f / MDV) + EPS);
        bf16_t* yp = Y + (row0 + t) * DMIX + 512 + hh * MDV + 4 * hi;
        const float* gp = gout + hh * MDV + 4 * hi;
#pragma unroll
        for (int vb = 0; vb < 4; ++vb)
#pragma unroll
            for (int g = 0; g < 4; ++g) {
                const f32x4 gg = *(const f32x4*)(gp + 32 * vb + 8 * g);
                u32x2 w; w.x = cvtpk(nm[vb][4 * g] * rs * gg[0], nm[vb][4 * g + 1] * rs * gg[1]); w.y = cvtpk(nm[vb][4 * g + 2] * rs * gg[2], nm[vb][4 * g + 3] * rs * gg[3]);
                *(u32x2*)(yp + 32 * vb + 8 * g) = w;
            }
    }
}


#define XB_TMO      128
#define XB_XCNT(j)  (256  + 64 * (j))
#define XB_XSUB(j)  (1280 + 64 * (j))
#define XB_XGEN(j)  (2304 + 64 * (j))
#define XB_TOP      3328
#define XB_TOPGEN   3392
#define XCD_BAR_WORDS 3456
#define XB_SPIN_CAP (1u << 22)
__device__ __forceinline__ unsigned xb_ld(unsigned* p)              { return __hip_atomic_load(p, __ATOMIC_RELAXED, __HIP_MEMORY_SCOPE_AGENT); }
__device__ __forceinline__ unsigned xb_add(unsigned* p, unsigned v) { return __hip_atomic_fetch_add(p, v, __ATOMIC_RELAXED, __HIP_MEMORY_SCOPE_AGENT); }
__device__ __forceinline__ unsigned xb_xcc_id() { return (unsigned)__builtin_amdgcn_s_getreg((3 << 11) | 20) & 0xFu; }
#define XB_SPIN(cond, bar) do { unsigned _sp = 0; while (cond) { __builtin_amdgcn_s_sleep(1); \
    if ((++_sp & 255u) == 0u) { if (xb_ld(&(bar)[XB_TMO])) break; if (_sp > XB_SPIN_CAP) { atomicAdd(&(bar)[XB_TMO], 1u); break; } } } } while (0)
struct XcdBarrier { unsigned* bar; unsigned x; volatile LAS unsigned* st; };
__device__ __forceinline__ XcdBarrier xcd_barrier_post(unsigned* bar, volatile LAS unsigned* st) {
    XcdBarrier b; b.bar = bar; b.x = xb_xcc_id(); b.st = st;
    if (threadIdx.x == 0) (void)xb_add(&bar[XB_XCNT(b.x)], 1u);
    return b;
}
__device__ __forceinline__ void xcd_barrier_complete(unsigned* bar, unsigned x, unsigned& nloc, unsigned& nx) {
    const unsigned G = gridDim.x * gridDim.y * gridDim.z;
    unsigned sum, cnt, mine, sp = 0u;
    for (;;) {
        sum = 0u; cnt = 0u; mine = 0u;
#pragma unroll
        for (unsigned j = 0; j < 16; ++j) { const unsigned c = xb_ld(&bar[XB_XCNT(j)]); sum += c; cnt += (c > 0u) ? 1u : 0u; mine = (j == x) ? c : mine; }
        if (sum == G) break;
        __builtin_amdgcn_s_sleep(1);
        if ((++sp & 255u) == 0u) { if (xb_ld(&bar[XB_TMO])) break; if (sp > XB_SPIN_CAP) { atomicAdd(&bar[XB_TMO], 1u); break; } }
    }
    nloc = mine > 0u ? mine : 1u; nx = cnt > 0u ? cnt : 1u;
}
__device__ __forceinline__ void xcd_barrier(const XcdBarrier& b) {
    asm volatile("s_waitcnt vmcnt(0)" ::: "memory");
    __syncthreads();
    if (threadIdx.x == 0) {
        unsigned* bar = b.bar;
        __builtin_amdgcn_s_waitcnt(0);
        unsigned nloc = b.st[0], nx = b.st[1];
        if (nloc == 0u) { xcd_barrier_complete(bar, b.x, nloc, nx); b.st[0] = nloc; b.st[1] = nx; }
        const unsigned old = xb_add(&bar[XB_XSUB(b.x)], 1u);
        const unsigned gen = old / nloc;
        if (old + 1u == (gen + 1u) * nloc) {
            __builtin_amdgcn_fence(__ATOMIC_RELEASE, "agent");
            asm volatile("s_waitcnt vmcnt(0)" ::: "memory");
            const unsigned og = xb_add(&bar[XB_TOP], 1u);
            const unsigned tg = og / nx;
            if (og + 1u == (tg + 1u) * nx) xb_add(&bar[XB_TOPGEN], 1u);
            else XB_SPIN(xb_ld(&bar[XB_TOPGEN]) == tg, bar);
            __builtin_amdgcn_fence(__ATOMIC_ACQUIRE, "agent");
            xb_add(&bar[XB_XGEN(b.x)], 1u);
            asm volatile("s_waitcnt vmcnt(0)" ::: "memory");
        } else {
            XB_SPIN(xb_ld(&bar[XB_XGEN(b.x)]) == gen, bar);
            __builtin_amdgcn_fence(__ATOMIC_ACQUIRE, "agent");
            asm volatile("s_waitcnt vmcnt(0)" ::: "memory");
        }
    }
    __syncthreads();
}

struct Args { const void* in[22]; float* out; unsigned char* ws; };
#ifndef PHASE_MASK
#define PHASE_MASK 0xFFFF
#endif
#define PH(n) (((PHASE_MASK) >> (n)) & 1)
#ifndef DUP_MASK
#define DUP_MASK 0
#endif
#define DUP(n) (1 + (((DUP_MASK) >> (n)) & 1))
constexpr int LDS_BYTES = 147456;

__global__ void __launch_bounds__(512, 2) fwd_megakernel(Args a) {
    extern __shared__ __attribute__((aligned(16))) unsigned char lds_raw[];
    cg::grid_group grid = cg::this_grid();
    LAS unsigned char* lds = (LAS unsigned char*)lds_raw;
    const int wave = __builtin_amdgcn_readfirstlane((int)threadIdx.x >> 6);
    const int G = gridDim.x, bx = blockIdx.x;
    const int gw = bx * 8 + wave, NGW = G * 8;
    const int NT = G * 512;
#define FRESH_IDS() int lane = fresh_lane(); const int tid = wave * 64 + lane; const int gtid = bx * 512 + tid; (void)tid; (void)gtid

    const float* x = (const float*)a.in[0]; const float* cvec = (const float*)a.in[1]; const int* positions = (const int*)a.in[2];
    const float* w_ada = (const float*)a.in[3]; const float* b_ada = (const float*)a.in[4]; const float* g_mix = (const float*)a.in[5];
    const float* w_in = (const float*)a.in[6]; const float* g_q = (const float*)a.in[7]; const float* w_uq = (const float*)a.in[8];
    const float* g_kv = (const float*)a.in[9]; const float* w_ukv = (const float*)a.in[10]; const float* conv_w = (const float*)a.in[11];
    const float* conv_b = (const float*)a.in[12]; const float* b_gates = (const float*)a.in[13]; const float* g_out_mla = (const float*)a.in[14];
    const float* g_out_mlstm = (const float*)a.in[15]; const float* w_out = (const float*)a.in[16]; const float* g_ffn = (const float*)a.in[17];
    const float* w_gate = (const float*)a.in[18]; const float* w_up = (const float*)a.in[19]; const float* w_down = (const float*)a.in[20];
    const float* g_final = (const float*)a.in[21];
    float* out = a.out; unsigned char* ws = a.ws;
    float* mod = (float*)(ws + WS_MOD); float* cosT = (float*)(ws + WS_COS); float* sinT = (float*)(ws + WS_SIN);
    float* rstdq = (float*)(ws + WS_RSTDQ); float* rstdkv = (float*)(ws + WS_RSTDKV); float* gates = (float*)(ws + WS_GATES);
    float* mloc = (float*)(ws + WS_MLOC); float* btot = (float*)(ws + WS_BTOT); float* m0buf = (float*)(ws + WS_M0);
    float* dn = (float*)(ws + WS_DN); float* n0buf = (float*)(ws + WS_N0);
    bf16_t* Bin = (bf16_t*)(ws + WS_BIN); bf16_t* Bq = (bf16_t*)(ws + WS_BQ); bf16_t* Bkv = (bf16_t*)(ws + WS_BKV); bf16_t* Bout = (bf16_t*)(ws + WS_BOUT);
    bf16_t* Bgu = (bf16_t*)(ws + WS_BGU); bf16_t* Bd = (bf16_t*)(ws + WS_BD); bf16_t* Krope = (bf16_t*)(ws + WS_KROPE);
    bf16_t* HN = (bf16_t*)(ws + WS_HN); bf16_t* Z = (bf16_t*)(ws + WS_Z); bf16_t* Qb = (bf16_t*)(ws + WS_Q); bf16_t* Kn = (bf16_t*)(ws + WS_KN);
    bf16_t* Vt = (bf16_t*)(ws + WS_VT); bf16_t* Qm = (bf16_t*)(ws + WS_QM); bf16_t* Km = (bf16_t*)(ws + WS_KM);
    float* dC = (float*)(ws + WS_DC); bf16_t* C0 = (bf16_t*)(ws + WS_C0); bf16_t* ACT = (bf16_t*)(ws + WS_ACT);

    unsigned* barw = (unsigned*)(ws + WS_BARW);
    volatile LAS unsigned* bst = (volatile LAS unsigned*)(lds + 131072 + 512);
    if (threadIdx.x < 2) bst[threadIdx.x] = 0u;
    __syncthreads();
    if (G == 0x7fffffff) grid.sync();
    const XcdBarrier xbar = xcd_barrier_post(barw, bst);
    if constexpr (PH(0)) _Pragma("unroll") for (int rep_ = 0; rep_ < DUP(0); ++rep_) {
        FRESH_IDS();
        LAS float* sc = (LAS float*)lds;
        LAS float* part = (LAS float*)(lds + 32768);
        if (bx < 192) {
            for (int i = tid; i < NB * DM; i += 512) sc[i] = siluf(cvec[i]);
            __syncthreads();
            const int col = tid & 31, ks = tid >> 5, n0 = 32 * bx;
            float acc[8];
#pragma unroll
            for (int b = 0; b < 8; ++b) acc[b] = 0.f;
#pragma unroll 16
            for (int kk = 0; kk < 64; ++kk) { const int k = ks * 64 + kk; const float w = __builtin_nontemporal_load(w_ada + (size_t)k * 6144 + n0 + col);
#pragma unroll
                for (int b = 0; b < 8; ++b) acc[b] += sc[b * DM + k] * w; }
#pragma unroll
            for (int b = 0; b < 8; ++b) part[(ks * 8 + b) * 32 + col] = acc[b];
            __syncthreads();
            if (tid < 256) { const int b = tid >> 5; float s = b_ada[n0 + col];
#pragma unroll
                for (int k2 = 0; k2 < 16; ++k2) s += part[(k2 * 8 + b) * 32 + col];
                mod[b * 6144 + n0 + col] = s; }
            __syncthreads();
        }
        if (gtid < 256) ((unsigned*)(ws + WS_PCNT))[gtid] = 0u;
        for (int idx = gtid; idx < MROWS * 16; idx += NT) {
            const int row = idx >> 4, i = idx & 15;
            const float inv = powf(10000.f, -(float)i / 16.f);
            const float ang = (float)positions[row] * inv;
            float sn, cs; sincosf(ang, &sn, &cs);
            cosT[idx] = cs; sinT[idx] = sn;
        }
        LAS float* scr = (LAS float*)(lds + wave * 16384);
        constexpr int I_IN = 16 * 72, I_Q = 6 * 24, I_KV = 4 * 32, I_OUT = 16 * 32, I_G = 16 * 88, I_D = 44 * 32;
        constexpr int NITEMS = I_IN + I_Q + I_KV + I_OUT + 2 * I_G + I_D;
        for (int it = gw; it < NITEMS; it += NGW) {
            int r = it;
            if (r < I_IN) { transpose_item(w_in, 1024, DIN, DINP, Bin, 0, nullptr, scr, r, lane); continue; } r -= I_IN;
            if (r < I_Q) { transpose_item(w_uq, QRANK, 768, 768, Bq, 1, g_q, scr, r, lane); continue; } r -= I_Q;
            if (r < I_KV) { transpose_item(w_ukv, KVRANK, 1024, 1024, Bkv, 0, g_kv, scr, r, lane); continue; } r -= I_KV;
            if (r < I_OUT) { transpose_item(w_out, 1024, 1024, 1024, Bout, 0, nullptr, scr, r, lane); continue; } r -= I_OUT;
            if (r < I_G) { transpose_item(w_gate, 1024, DFF, DFF, Bgu, 2, nullptr, scr, r, lane); continue; } r -= I_G;
            if (r < I_G) { transpose_item(w_up, 1024, DFF, DFF, Bgu, 3, nullptr, scr, r, lane); continue; } r -= I_G;
            transpose_item(w_down, DFF, 1024, 1024, Bd, 0, nullptr, scr, r, lane);
        }
        if constexpr (DUP(0) == 2) __syncthreads();
    }
    xcd_barrier(xbar);

    if constexpr (PH(1)) _Pragma("unroll") for (int rep_ = 0; rep_ < DUP(1); ++rep_) { FRESH_IDS(); for (int row = gw; row < MROWS; row += NGW) {
        const int b = row >> 12;
        const f32x4* xr = (const f32x4*)(x + (size_t)row * DM) + lane;
        f32x4 v[4]; float s = 0.f;
#pragma unroll
        for (int j = 0; j < 4; ++j) { v[j] = __builtin_nontemporal_load(xr + 64 * j); s += v[j][0] * v[j][0] + v[j][1] * v[j][1] + v[j][2] * v[j][2] + v[j][3] * v[j][3]; }
        const float rstd = rsqrtf(wave_sum(s) * (1.f / DM) + EPS);
        unsigned long long* o8 = (unsigned long long*)(HN + (size_t)row * DM) + lane;
#pragma unroll
        for (int j = 0; j < 4; ++j) {
            const int col = 4 * lane + 256 * j;
            const f32x4 g = *(const f32x4*)(g_mix + col), sh = *(const f32x4*)(mod + b * 6144 + col), sc = *(const f32x4*)(mod + b * 6144 + 1024 + col);
            const f32x4 h = (v[j] * rstd * g) * (sc + 1.f) + sh;
            o8[64 * j] = (unsigned long long)cvtpk(h[0], h[1]) | ((unsigned long long)cvtpk(h[2], h[3]) << 32);
        }
    } }
    xcd_barrier(xbar);

    if constexpr (PH(2)) _Pragma("unroll") for (int rep_ = 0; rep_ < DUP(2); ++rep_) {
        pg8::Gemm g{HN, Bin, MROWS, DINP, 1024, 1024}; pg8::StaticOrder S; S.init(MROWS, DINP, G, bx);
        EpiIn E{Z, gates, b_gates};
        pg8::gemm_phase<EpiIn, true>(lds, g, S, E, wave);
    }
    xcd_barrier(xbar);

    if constexpr (PH(3)) _Pragma("unroll") for (int rep_ = 0; rep_ < DUP(3); ++rep_) { FRESH_IDS();
      for (int rowb = gw * 16; rowb < MROWS; rowb += NGW * 16) {
        const int b = rowb >> 12, sb = rowb & 4095;
        const int ch0 = 8 * lane;
        f32x4 cw[4][2];
#pragma unroll
        for (int w = 0; w < 4; ++w) { cw[w][0] = *(const f32x4*)(conv_w + w * 512 + ch0); cw[w][1] = *(const f32x4*)(conv_w + w * 512 + ch0 + 4); }
        const f32x4 cb0 = *(const f32x4*)(conv_b + ch0), cb1 = *(const f32x4*)(conv_b + ch0 + 4);
        const float mul = (lane < 32) ? 1.f : 0.125f;
        const int chh = ch0 & 255, hh = chh >> 6, d = chh & 63;
        u32x4 win[3];
#pragma unroll
        for (int w = 0; w < 3; ++w) win[w] = (sb - 3 + w >= 0) ? *(const u32x4*)(Z + (size_t)(rowb - 3 + w) * DINP + ZQK + ch0) : (u32x4){0u, 0u, 0u, 0u};
#pragma unroll 2
        for (int k = 0; k < 16; ++k) {
            const int row = rowb + k, s = sb + k;
            const bf16_t* zr = Z + (size_t)row * DINP;
            const u32x4 cur = *(const u32x4*)(zr + ZQK + ch0);
            float sq = 0.f, skv = 0.f;
            if (lane < 48) { const u32x4 u = *(const u32x4*)(zr + ZQ + 8 * lane);
                const float e0 = bflo(u.x), e1 = bfhi(u.x), e2 = bflo(u.y), e3 = bfhi(u.y), e4 = bflo(u.z), e5 = bfhi(u.z), e6 = bflo(u.w), e7 = bfhi(u.w);
                sq = e0 * e0 + e1 * e1 + e2 * e2 + e3 * e3 + e4 * e4 + e5 * e5 + e6 * e6 + e7 * e7; }
            if (lane < 32) { const u32x4 u = *(const u32x4*)(zr + ZKV + 8 * lane);
                const float e0 = bflo(u.x), e1 = bfhi(u.x), e2 = bflo(u.y), e3 = bfhi(u.y), e4 = bflo(u.z), e5 = bfhi(u.z), e6 = bflo(u.w), e7 = bfhi(u.w);
                skv = e0 * e0 + e1 * e1 + e2 * e2 + e3 * e3 + e4 * e4 + e5 * e5 + e6 * e6 + e7 * e7; }
            sq = wave_sum(sq); skv = wave_sum(skv);
            if (lane == 0) { rstdq[row] = rsqrtf(sq * (1.f / QRANK) + EPS); rstdkv[row] = rsqrtf(skv * (1.f / KVRANK) + EPS); }
            if (lane < 16) {
                const float x1 = bf2f(zr[ZKR + lane]), x2 = bf2f(zr[ZKR + 16 + lane]);
                const float cs = cosT[row * 16 + lane], sn = sinT[row * 16 + lane];
                *(unsigned*)(Krope + (size_t)row * DROPE + 2 * lane) = cvtpk(x1 * cs - x2 * sn, x2 * cs + x1 * sn);
            }
            float acc[8] = {cb0[0], cb0[1], cb0[2], cb0[3], cb1[0], cb1[1], cb1[2], cb1[3]};
#pragma unroll
            for (int w = 0; w < 4; ++w) {
                const u32x4 u = (w < 3) ? win[w] : cur;
                acc[0] += bflo(u.x) * cw[w][0][0]; acc[1] += bfhi(u.x) * cw[w][0][1]; acc[2] += bflo(u.y) * cw[w][0][2]; acc[3] += bfhi(u.y) * cw[w][0][3];
                acc[4] += bflo(u.z) * cw[w][1][0]; acc[5] += bfhi(u.z) * cw[w][1][1]; acc[6] += bflo(u.w) * cw[w][1][2]; acc[7] += bfhi(u.w) * cw[w][1][3];
            }
            win[0] = win[1]; win[1] = win[2]; win[2] = cur;
#pragma unroll
            for (int j = 0; j < 8; ++j) acc[j] = siluf(acc[j]) * mul;
            u32x4 o; o.x = cvtpk(acc[0], acc[1]); o.y = cvtpk(acc[2], acc[3]); o.z = cvtpk(acc[4], acc[5]); o.w = cvtpk(acc[6], acc[7]);
            bf16_t* dst = ((lane < 32) ? Qm : Km) + ((size_t)((b * MH + hh) * SEQ + s)) * MDK + d;
            *(u32x4*)dst = o;
        }
      } }
    xcd_barrier(xbar);

    if constexpr (PH(12)) _Pragma("unroll") for (int rep_ = 0; rep_ < DUP(12); ++rep_) { FRESH_IDS(); for (int ch = gw; ch < NCH_TOT; ch += NGW) mlstm_chunk_state(ch, Z, Km, gates, dC, dn, mloc, btot, lane); }
    __syncthreads();
    if constexpr (PH(4)) _Pragma("unroll") for (int rep_ = 0; rep_ < DUP(4); ++rep_) {
        pg8::Gemm g{Z + ZQ, Bq, MROWS, 768, QRANK, DINP}; pg8::StaticOrder S; S.init(MROWS, 768, G, bx);
        EpiQ E{Qb};
        pg8::gemm_phase<EpiQ, true>(lds, g, S, E, wave);
    }
    if constexpr (PH(14)) _Pragma("unroll") for (int rep_ = 0; rep_ < DUP(14); ++rep_) {
        pg8::Gemm g{Z + ZKV, Bkv, MROWS, 1024, KVRANK, DINP}; pg8::StaticOrder S; S.init(MROWS, 1024, G, bx);
        EpiKV E{Kn, Vt, rstdkv};
        pg8::gemm_phase<EpiKV, true>(lds, g, S, E, wave);
    }
    xcd_barrier(xbar);

    {
        const int vcu = (G % 8 == 0) ? (bx % 8) * (G / 8) + bx / 8 : bx;
        if constexpr (PH(13)) _Pragma("unroll") for (int rep_ = 0; rep_ < DUP(13); ++rep_) { FRESH_IDS();
          for (int g0 = bx * 512; g0 < NB * MH * 4096; g0 += NT) {
            const int bh = g0 >> 12, p = (g0 & 4095) + tid;
            float m = 0.f, ca = 0.f, cb = 0.f, na = 0.f, nb = 0.f;
#pragma unroll 1
            for (int c0 = 0; c0 < NCHUNK; c0 += 16) {
                f32x2_t d[16], dd[16]; float ml[16], bt[16];
#pragma unroll
                for (int j = 0; j < 16; ++j) {
                    const int ch = bh * NCHUNK + c0 + j;
                    d[j] = *(const f32x2_t*)(dC + (size_t)ch * 8192 + 2 * p);
                    dd[j] = (p < 32) ? *(const f32x2_t*)(dn + (size_t)ch * 64 + 2 * p) : (f32x2_t){0.f, 0.f};
                    ml[j] = mloc[ch]; bt[j] = btot[ch];
                }
#pragma unroll
                for (int j = 0; j < 16; ++j) {
                    const int ch = bh * NCHUNK + c0 + j;
                    *(unsigned*)(C0 + (size_t)ch * 8192 + 2 * p) = cvtpk(ca, cb);
                    if (p < 32) { *(f32x2_t*)(n0buf + (size_t)ch * 64 + 2 * p) = (f32x2_t){na, nb}; if (p == 0) m0buf[ch] = m; }
                    const float mnew = fmaxf(bt[j] + m, ml[j]);
                    const float av = __expf(bt[j] + m - mnew), ev = __expf(ml[j] - mnew);
                    na = av * na + ev * dd[j][0]; nb = av * nb + ev * dd[j][1];
                    ca = av * ca + ev * d[j][0]; cb = av * cb + ev * d[j][1];
                    m = mnew;
                }
            }
          }
        }
        if constexpr (PH(5)) _Pragma("unroll") for (int rep_ = 0; rep_ < DUP(5); ++rep_) { FRESH_IDS(); for (int v = vcu; v < 256; v += G) {
            const int bh = v >> 2, sidx = v & 3;
#pragma unroll 1
            for (int i = 0; i < 2; ++i) {
                const int qb = (i == 0) ? sidx : 7 - sidx;
                attn_unit(lds, Qb, Kn, Krope, Vt, HN, g_out_mla, rstdq, cosT, sinT, bh >> 3, bh & 7, qb, wave, lane);
            }
        } }
    }
    xcd_barrier(xbar);

    if constexpr (PH(6)) _Pragma("unroll") for (int rep_ = 0; rep_ < DUP(6); ++rep_) { FRESH_IDS(); for (int ch = gw; ch < NCH_TOT; ch += NGW) mlstm_chunk_out(ch, Z, Qm, Km, gates, C0, n0buf, m0buf, g_out_mlstm, HN, lane); }
    xcd_barrier(xbar);

    if constexpr (PH(7)) _Pragma("unroll") for (int rep_ = 0; rep_ < DUP(7); ++rep_) {
        pg8::Gemm g{HN, Bout, MROWS, 1024, 1024, 1024}; pg8::StaticOrder S; S.init(MROWS, 1024, G, bx);
        EpiRes E{x, out, mod + 2048};
        pg8::gemm_phase<EpiRes, true>(lds, g, S, E, wave);
    }
    xcd_barrier(xbar);

    if constexpr (PH(8)) _Pragma("unroll") for (int rep_ = 0; rep_ < DUP(8); ++rep_) { FRESH_IDS(); for (int row = gw; row < MROWS; row += NGW) {
        const int b = row >> 12;
        const f32x4* xr = (const f32x4*)(out + (size_t)row * DM) + lane;
        f32x4 v[4]; float s = 0.f;
#pragma unroll
        for (int j = 0; j < 4; ++j) { v[j] = __builtin_nontemporal_load(xr + 64 * j); s += v[j][0] * v[j][0] + v[j][1] * v[j][1] + v[j][2] * v[j][2] + v[j][3] * v[j][3]; }
        const float rstd = rsqrtf(wave_sum(s) * (1.f / DM) + EPS);
        unsigned long long* o8 = (unsigned long long*)(HN + (size_t)row * DM) + lane;
#pragma unroll
        for (int j = 0; j < 4; ++j) {
            const int col = 4 * lane + 256 * j;
            const f32x4 g = *(const f32x4*)(g_ffn + col), sh = *(const f32x4*)(mod + b * 6144 + 3072 + col), sc = *(const f32x4*)(mod + b * 6144 + 4096 + col);
            const f32x4 h = (v[j] * rstd * g) * (sc + 1.f) + sh;
            o8[64 * j] = (unsigned long long)cvtpk(h[0], h[1]) | ((unsigned long long)cvtpk(h[2], h[3]) << 32);
        }
    } }
    xcd_barrier(xbar);

    if constexpr (PH(9)) _Pragma("unroll") for (int rep_ = 0; rep_ < DUP(9); ++rep_) {
        pg8::Gemm g{HN, Bgu, MROWS, 2 * DFF, 1024, 1024}; pg8::StaticOrder S; S.init(MROWS, 2 * DFF, G, bx);
        EpiGU E{ACT};
        pg8::gemm_phase<EpiGU, true>(lds, g, S, E, wave);
    }
    xcd_barrier(xbar);

    if constexpr (DUP(10) == 2) {
        pg8::Gemm g{ACT, Bd, MROWS, 1024, DFF, DFF}; pg8::StaticOrder S; S.init(MROWS, 1024, G, bx);
        EpiRes E{out, (float*)(ws + 288 * MiB), mod + 5120};
        pg8::gemm_phase<EpiRes, true>(lds, g, S, E, wave);
    }
    if (G == 256) {
        pg8::Gemm g{ACT, Bd, MROWS, 1024, DFF, DFF}; pg8::StaticOrder S; S.init(MROWS, 1024, G, bx);
        EpiResNorm E{out, out, mod + 5120, g_final, (float*)(ws + WS_XBUF), (unsigned*)(ws + WS_PCNT), lds + 131072 + 2048};
        pg8::gemm_phase<EpiResNorm, true>(lds, g, S, E, wave);
    } else {
        {
            pg8::Gemm g{ACT, Bd, MROWS, 1024, DFF, DFF}; pg8::StaticOrder S; S.init(MROWS, 1024, G, bx);
            EpiRes E{out, out, mod + 5120};
            pg8::gemm_phase<EpiRes, true>(lds, g, S, E, wave);
        }
        xcd_barrier(xbar);
        { FRESH_IDS(); for (int row = gw; row < MROWS; row += NGW) {
            f32x4* xr = (f32x4*)(out + (size_t)row * DM) + lane;
            f32x4 v[4]; float s = 0.f;
#pragma unroll
            for (int j = 0; j < 4; ++j) { v[j] = xr[64 * j]; s += v[j][0] * v[j][0] + v[j][1] * v[j][1] + v[j][2] * v[j][2] + v[j][3] * v[j][3]; }
            const float rstd = rsqrtf(wave_sum(s) * (1.f / DM) + EPS);
#pragma unroll
            for (int j = 0; j < 4; ++j) { const f32x4 g = *(const f32x4*)(g_final + 4 * lane + 256 * j); xr[64 * j] = v[j] * rstd * g; }
        } }
    }
}

extern "C" void kernel_launch(void* const* d_in, const int* in_sizes, int n_in, void* d_out, int out_size, void* d_ws, size_t ws_size, hipStream_t stream) {
    static int grid_blocks = 0;
    if (grid_blocks == 0) {
        if (n_in != 22 || ws_size < WS_END) { fprintf(stderr, "kernel_launch: unexpected n_in %d / ws_size %zu (need %zu)\n", n_in, ws_size, (size_t)WS_END); grid_blocks = -1; return; }
        int dev = 0, cus = 0, per_cu = 0;
        hipGetDevice(&dev);
        hipDeviceGetAttribute(&cus, hipDeviceAttributeMultiprocessorCount, dev);
        if (hipFuncSetAttribute((const void*)fwd_megakernel, hipFuncAttributeMaxDynamicSharedMemorySize, LDS_BYTES) != hipSuccess) fprintf(stderr, "kernel_launch: hipFuncSetAttribute failed\n");
        if (hipOccupancyMaxActiveBlocksPerMultiprocessor(&per_cu, (const void*)fwd_megakernel, 512, LDS_BYTES) != hipSuccess || per_cu < 1) { fprintf(stderr, "kernel_launch: occupancy query gave %d\n", per_cu); per_cu = 1; }
        (void)hipGetLastError();
        grid_blocks = cus;
        if (grid_blocks > 256) grid_blocks = 256;
    }
    if (grid_blocks < 0) return;
    Args a{};
    for (int i = 0; i < 22; ++i) a.in[i] = d_in[i];
    a.out = (float*)d_out; a.ws = (unsigned char*)d_ws;
    if (hipMemsetAsync((unsigned char*)d_ws + WS_BARW, 0, XCD_BAR_WORDS * 4, stream) != hipSuccess) { fprintf(stderr, "kernel_launch: memset of the barrier words failed\n"); return; }
    void* args[] = {&a};
    hipError_t e = hipLaunchCooperativeKernel((const void*)fwd_megakernel, dim3(grid_blocks), dim3(512), args, LDS_BYTES, stream);
    if (e != hipSuccess) fprintf(stderr, "cooperative launch failed: %s (grid %d)\n", hipGetErrorString(e), grid_blocks);
}
```
